# Optimizing an MI355X kernel written in HIP

```python
import math
import jax, jax.numpy as jnp
from jax import lax
import numpy as np

D_MODEL = 2048
BATCH = 4
SEQ = 4096
DEPTH = 1

HEAD_DIM = 128
ATTN_HEADS = 8
ATTN_KV_HEADS = 2
ATTN_GROUP = ATTN_HEADS // ATTN_KV_HEADS
WINDOW = 128
ATTN_BLOCK = 128
N_BUCKETS = 32
MAX_DISTANCE = 128
DN_HEADS = 8
DN_KEY_DIM = 128
DN_VAL_DIM = 128
CONV_WIDTH = 5
DN_CHUNK = 64
MIX_WIDTH = ATTN_HEADS * HEAD_DIM + DN_HEADS * DN_VAL_DIM
PEER_HEADS = 8
PEER_NKEYS = 128
PEER_EXPERTS = PEER_NKEYS * PEER_NKEYS
PEER_QDIM = 256
PEER_HALF = PEER_QDIM // 2
PEER_TOPK = 16
PEER_BLOCK = 128
DEEPNORM_ALPHA = (2.0 * DEPTH) ** 0.25
DEEPNORM_BETA = (8.0 * DEPTH) ** -0.25
LN_EPS = 1e-5
RMS_EPS = 1e-6

SPLIT_SIZES = (ATTN_HEADS * HEAD_DIM, ATTN_KV_HEADS * HEAD_DIM, ATTN_KV_HEADS * HEAD_DIM,
               DN_HEADS * DN_KEY_DIM, DN_HEADS * DN_KEY_DIM, DN_HEADS * DN_VAL_DIM, DN_HEADS * DN_VAL_DIM,
               2 * DN_HEADS, 2 * DN_HEADS)
IN_WIDTH = int(sum(SPLIT_SIZES))
SPLIT_POINTS = tuple(int(c) for c in np.cumsum(SPLIT_SIZES)[:-1])
CONV_CH = 2 * DN_HEADS * DN_KEY_DIM + DN_HEADS * DN_VAL_DIM

kernel_name = "hymba_swa_gdn_peer_deepnorm"


def _layer_norm(x, g, b):
    xf = x.astype(jnp.float32)
    mu = jnp.mean(xf, axis=-1, keepdims=True)
    var = jnp.mean(jnp.square(xf - mu), axis=-1, keepdims=True)
    return ((xf - mu) * lax.rsqrt(var + LN_EPS) * g.astype(jnp.float32) + b.astype(jnp.float32)).astype(x.dtype)


def _l2norm(t):
    return t * lax.rsqrt(jnp.sum(t * t, axis=-1, keepdims=True) + RMS_EPS)


def _t5_bucket(rel):
    nb = N_BUCKETS // 2
    max_exact = nb // 2
    ret = jnp.where(rel > 0, nb, 0)
    n = jnp.abs(rel)
    large = max_exact + (jnp.log(jnp.maximum(n, 1).astype(jnp.float32) / max_exact)
                         / math.log(MAX_DISTANCE / max_exact) * (nb - max_exact)).astype(jnp.int32)
    large = jnp.minimum(large, nb - 1)
    return ret + jnp.where(n < max_exact, n, large)


def _window_attention(q, k, v, sink, rel_bias):
    B, S = q.shape[0], q.shape[1]
    nb = S // ATTN_BLOCK
    qb = q.reshape(B, nb, ATTN_BLOCK, ATTN_KV_HEADS, ATTN_GROUP, HEAD_DIM)

    def band(t):
        tp = jnp.pad(t, ((0, 0), (ATTN_BLOCK, ATTN_BLOCK), (0, 0), (0, 0)))
        parts = [tp[:, o * ATTN_BLOCK: o * ATTN_BLOCK + S].reshape(B, nb, ATTN_BLOCK, ATTN_KV_HEADS, HEAD_DIM)
                 for o in range(3)]
        return jnp.concatenate(parts, axis=2)

    kb, vb = band(k), band(v)
    rel = jnp.arange(3 * ATTN_BLOCK)[None, :] - jnp.arange(ATTN_BLOCK)[:, None] - ATTN_BLOCK
    bias = rel_bias[_t5_bucket(rel)]
    bias = jnp.transpose(bias, (2, 0, 1)).reshape(ATTN_KV_HEADS, ATTN_GROUP, ATTN_BLOCK, 3 * ATTN_BLOCK)
    kpos = (jnp.arange(nb)[:, None] - 1) * ATTN_BLOCK + jnp.arange(3 * ATTN_BLOCK)[None, :]
    mask = (jnp.abs(rel) <= WINDOW)[None] & ((kpos >= 0) & (kpos < S))[:, None, :]
    s = (jnp.einsum('bnqhgd,bnkhd->bnhgqk', qb, kb).astype(jnp.float32) * (HEAD_DIM ** -0.5)
         + bias.astype(jnp.float32))
    s = jnp.where(mask[None, :, None, None], s, -jnp.inf)
    sk = sink.astype(jnp.float32).reshape(1, 1, ATTN_KV_HEADS, ATTN_GROUP, 1, 1)
    m = jnp.maximum(jnp.max(s, axis=-1, keepdims=True), sk)
    p = jnp.exp(s - m)
    den = jnp.sum(p, axis=-1, keepdims=True) + jnp.exp(sk - m)
    o = jnp.einsum('bnhgqk,bnkhd->bnqhgd', (p / den).astype(v.dtype), vb)
    return o.reshape(B, S, ATTN_HEADS * HEAD_DIM)


def _short_conv(x, w):
    pad = CONV_WIDTH // 2
    y = lax.conv_general_dilated(x, w[:, None, :].astype(x.dtype), window_strides=(1,),
                                 padding=((pad, pad),), dimension_numbers=('NWC', 'WIO', 'NWC'),
                                 feature_group_count=x.shape[-1])
    return jax.nn.silu(y)


def _chunk_gated_delta(q, k, v, g, beta):
    B, H, S, Dk = q.shape
    Dv = v.shape[-1]
    C = DN_CHUNK
    N = S // C
    chunks = lambda t: t.reshape((B, H, N, C) + t.shape[3:])
    q = chunks(q * (Dk ** -0.5))
    k = chunks(k)
    v = chunks(v)
    beta = chunks(beta)
    g = jnp.cumsum(chunks(g), axis=-1)
    incl = jnp.tril(jnp.ones((C, C), bool))
    strict = jnp.tril(jnp.ones((C, C), bool), -1)
    diff = g[..., :, None] - g[..., None, :]
    decay = jnp.where(incl, jnp.exp(jnp.where(incl, diff, 0.0)), 0.0)
    kb = k * beta[..., None]
    L = jnp.where(strict, jnp.einsum('bhnid,bhnjd->bhnij', kb, k) * decay, 0.0)
    eye = jnp.eye(C, dtype=L.dtype)
    T = lax.linalg.triangular_solve(L + eye, jnp.broadcast_to(eye, L.shape), left_side=True,
                                    lower=True, unit_diagonal=True)
    u = T @ (v * beta[..., None])
    w = T @ (kb * jnp.exp(g)[..., None])
    A = jnp.einsum('bhnid,bhnjd->bhnij', q, k) * decay
    qg = q * jnp.exp(g)[..., None]
    kd = k * jnp.exp(g[..., -1:] - g)[..., None]
    gl = jnp.exp(g[..., -1])

    def step(state, inp):
        qg_i, kd_i, u_i, w_i, A_i, gl_i = inp
        v_new = u_i - w_i @ state
        o = qg_i @ state + A_i @ v_new
        state = state * gl_i[..., None, None] + jnp.einsum('bhck,bhcv->bhkv', kd_i, v_new)
        return state, o

    xs = tuple(jnp.moveaxis(t, 2, 0) for t in (qg, kd, u, w, A, gl))
    _, o = lax.scan(step, jnp.zeros((B, H, Dk, Dv), q.dtype), xs)
    return jnp.moveaxis(o, 0, 2).reshape(B, H, S, Dv)


def _deltanet(dq, dk, dv, dz, dbeta, da, conv_w, a_log, dt_bias, norm_w):
    B, S = dq.shape[0], dq.shape[1]
    f32 = jnp.float32
    qkv = _short_conv(jnp.concatenate([dq, dk, dv], axis=-1), conv_w)
    q, k, v = jnp.split(qkv, [DN_HEADS * DN_KEY_DIM, 2 * DN_HEADS * DN_KEY_DIM], axis=-1)
    heads = lambda t, d: t.reshape(B, S, DN_HEADS, d).transpose(0, 2, 1, 3).astype(f32)
    q = _l2norm(heads(q, DN_KEY_DIM))
    k = _l2norm(heads(k, DN_KEY_DIM))
    v = heads(v, DN_VAL_DIM)
    beta = jax.nn.sigmoid(dbeta.astype(f32)).reshape(B, S, 2, DN_HEADS).transpose(2, 0, 3, 1)
    a = da.astype(f32).reshape(B, S, 2, DN_HEADS).transpose(2, 0, 3, 1)
    g = -jnp.exp(a_log.astype(f32))[:, None, :, None] * jax.nn.softplus(a + dt_bias.astype(f32)[:, None, :, None])
    o_fwd = _chunk_gated_delta(q, k, v, g[0], beta[0])
    flip = lambda t: jnp.flip(t, axis=2)
    o_bwd = flip(_chunk_gated_delta(flip(q), flip(k), flip(v), flip(g[1]), flip(beta[1])))
    o = (o_fwd + o_bwd).transpose(0, 2, 1, 3)
    o = o * lax.rsqrt(jnp.mean(o * o, axis=-1, keepdims=True) + RMS_EPS) * norm_w.astype(f32)
    z = dz.reshape(B, S, DN_HEADS, DN_VAL_DIM).astype(f32)
    return (o * jax.nn.silu(z)).reshape(B, S, DN_HEADS * DN_VAL_DIM).astype(dq.dtype)


def _peer(h, wq, keys, u, v):
    B, S, D = h.shape
    T = B * S
    t = h.reshape(T, D)
    q = (t @ wq).reshape(T, PEER_HEADS, 2, PEER_HALF)
    s = jnp.einsum('thpd,pkd->thpk', q, keys).astype(jnp.float32)
    sv, si = lax.top_k(s, PEER_TOPK)
    cand = (sv[:, :, 0, :, None] + sv[:, :, 1, None, :]).reshape(T, PEER_HEADS, PEER_TOPK * PEER_TOPK)
    cidx = (si[:, :, 0, :, None] * PEER_NKEYS + si[:, :, 1, None, :]).reshape(T, PEER_HEADS, PEER_TOPK * PEER_TOPK)
    top_s, top_c = lax.top_k(cand, PEER_TOPK)
    eidx = jnp.take_along_axis(cidx, top_c, axis=-1).reshape(T, PEER_HEADS * PEER_TOPK)
    gate = jax.nn.softmax(top_s, axis=-1).reshape(T, PEER_HEADS * PEER_TOPK).astype(h.dtype)
    nblk = T // PEER_BLOCK

    def block(args):
        tb, ib, gb = args
        act = jax.nn.gelu(jnp.einsum('tpd,td->tp', u[ib], tb), approximate=False)
        return jnp.einsum('tp,tpd->td', act * gb, v[ib])

    out = lax.map(block, (t.reshape(nblk, PEER_BLOCK, D),
                          eidx.reshape(nblk, PEER_BLOCK, PEER_HEADS * PEER_TOPK),
                          gate.reshape(nblk, PEER_BLOCK, PEER_HEADS * PEER_TOPK)))
    return out.reshape(B, S, D)


def _layer(x, w_in, conv_w, a_log, dt_bias, dn_norm_w, attn_sink, rel_bias, w_out,
           ln1_g, ln1_b, peer_wq, peer_keys, peer_u, peer_v, ln2_g, ln2_b):
    B, S = x.shape[0], x.shape[1]
    proj = x @ w_in
    aq, ak, av, dq, dk, dv, dz, dbeta, da = jnp.split(proj, SPLIT_POINTS, axis=-1)
    attn = _window_attention(aq.reshape(B, S, ATTN_HEADS, HEAD_DIM),
                             ak.reshape(B, S, ATTN_KV_HEADS, HEAD_DIM),
                             av.reshape(B, S, ATTN_KV_HEADS, HEAD_DIM), attn_sink, rel_bias)
    dn = _deltanet(dq, dk, dv, dz, dbeta, da, conv_w, a_log, dt_bias, dn_norm_w)
    mix = jnp.concatenate([attn, dn], axis=-1) @ w_out
    h = _layer_norm(DEEPNORM_ALPHA * x + mix, ln1_g, ln1_b)
    return _layer_norm(DEEPNORM_ALPHA * h + _peer(h, peer_wq, peer_keys, peer_u, peer_v), ln2_g, ln2_b)


def setup_inputs(seed: int = 0) -> dict:
    key = jax.random.key(seed)
    ks = jax.random.split(key, 17)
    f32 = jnp.float32
    nrm = lambda k, shape, scale: jax.random.normal(k, shape, f32) * scale
    x = nrm(ks[0], (BATCH, SEQ, D_MODEL), 1.0)
    w_in = nrm(ks[1], (DEPTH, D_MODEL, IN_WIDTH), D_MODEL ** -0.5)
    conv_w = nrm(ks[2], (DEPTH, CONV_WIDTH, CONV_CH), CONV_WIDTH ** -0.5)
    a_log = jnp.log(jax.random.uniform(ks[3], (DEPTH, 2, DN_HEADS), f32, 1.0, 16.0))
    dt = jnp.exp(jax.random.uniform(ks[4], (DEPTH, 2, DN_HEADS), f32, math.log(1e-3), math.log(1e-1)))
    dt_bias = dt + jnp.log(-jnp.expm1(-dt))
    dn_norm_w = 1.0 + nrm(ks[5], (DEPTH, DN_VAL_DIM), 0.02)
    attn_sink = nrm(ks[6], (DEPTH, ATTN_HEADS), 0.5)
    rel_bias = nrm(ks[7], (N_BUCKETS, ATTN_HEADS), 0.5)
    w_out = nrm(ks[8], (DEPTH, MIX_WIDTH, D_MODEL), MIX_WIDTH ** -0.5 * DEEPNORM_BETA)
    ln1_g = 1.0 + nrm(ks[9], (DEPTH, D_MODEL), 0.02)
    ln1_b = nrm(ks[10], (DEPTH, D_MODEL), 0.02)
    peer_wq = nrm(ks[11], (DEPTH, D_MODEL, PEER_HEADS * PEER_QDIM), D_MODEL ** -0.5)
    peer_keys = nrm(ks[12], (DEPTH, 2, PEER_NKEYS, PEER_HALF), PEER_HALF ** -0.5)
    peer_u = nrm(ks[13], (DEPTH, PEER_EXPERTS, D_MODEL), D_MODEL ** -0.5)
    peer_v = nrm(ks[14], (DEPTH, PEER_EXPERTS, D_MODEL), DEEPNORM_BETA * PEER_HEADS ** -0.5)
    ln2_g = 1.0 + nrm(ks[15], (DEPTH, D_MODEL), 0.02)
    ln2_b = nrm(ks[16], (DEPTH, D_MODEL), 0.02)
    return {"x": x, "w_in": w_in, "conv_w": conv_w, "a_log": a_log, "dt_bias": dt_bias,
            "dn_norm_w": dn_norm_w, "attn_sink": attn_sink, "rel_bias": rel_bias, "w_out": w_out,
            "ln1_g": ln1_g, "ln1_b": ln1_b, "peer_wq": peer_wq, "peer_keys": peer_keys,
            "peer_u": peer_u, "peer_v": peer_v, "ln2_g": ln2_g, "ln2_b": ln2_b}


def reference(x, w_in, conv_w, a_log, dt_bias, dn_norm_w, attn_sink, rel_bias, w_out,
              ln1_g, ln1_b, peer_wq, peer_keys, peer_u, peer_v, ln2_g, ln2_b):
    for l in range(DEPTH):
        x = _layer(x, w_in[l], conv_w[l], a_log[l], dt_bias[l], dn_norm_w[l], attn_sink[l], rel_bias,
                   w_out[l], ln1_g[l], ln1_b[l], peer_wq[l], peer_keys[l], peer_u[l], peer_v[l],
                   ln2_g[l], ln2_b[l])
    return x
```

```cpp
#include <hip/hip_runtime.h>
#include <cstdio>
#include <cstdint>
#include <cmath>

namespace {
constexpr int D = 2048, NB = 4, S = 4096, T = NB * S;
constexpr int INW = 5664;
constexpr int O_AQ = 0, O_AK = 1024, O_AV = 1280, O_DQ = 1536, O_DK = 2560, O_DV = 3584, O_DZ = 4608, O_DB = 5632, O_DA = 5648;
constexpr float ALPHA = 1.189207115002721f;
constexpr float LN_EPS = 1e-5f, RMS_EPS = 1e-6f;
constexpr size_t MB = 1024ull * 1024ull;

__device__ __forceinline__ float wave_sum(float v) {
#pragma unroll
    for (int o = 1; o < 64; o <<= 1) v += __shfl_xor(v, o);
    return v;
}
__device__ __forceinline__ float wave_max(float v) {
#pragma unroll
    for (int o = 1; o < 64; o <<= 1) v = fmaxf(v, __shfl_xor(v, o));
    return v;
}
__device__ __forceinline__ float silu_f(float x) { return x / (1.0f + expf(-x)); }
__device__ __forceinline__ float sigmoid_f(float x) { return 1.0f / (1.0f + expf(-x)); }
__device__ __forceinline__ float softplus_f(float x) { return fmaxf(x, 0.f) + log1pf(expf(-fabsf(x))); }
__device__ __forceinline__ int t5_bucket(int rel) {
    int n = rel < 0 ? -rel : rel;
    int v;
    if (n < 8) v = n; else if (n < 12) v = 8; else if (n < 16) v = 9; else if (n < 23) v = 10; else if (n < 32) v = 11;
    else if (n < 46) v = 12; else if (n < 64) v = 13; else if (n < 91) v = 14; else v = 15;
    return v + (rel > 0 ? 16 : 0);
}

__global__ void __launch_bounds__(256) k_gemm_f32(const float* __restrict__ A, int lda, const float* __restrict__ Bm, int ldb, float* __restrict__ C, int ldc,
                                                  int M, int N, int K, const float* __restrict__ X, int ldx, float alpha) {
    __shared__ float As[16][68];
    __shared__ float Bs[16][68];
    const int tid = threadIdx.x, ty = tid >> 4, tx = tid & 15;
    const int ntn = (N + 63) / 64;
    const int bm = blockIdx.x / ntn, bn = blockIdx.x % ntn;
    const int row0 = bm * 64, col0 = bn * 64;
    float acc[4][4];
#pragma unroll
    for (int i = 0; i < 4; ++i)
#pragma unroll
        for (int j = 0; j < 4; ++j) acc[i][j] = 0.f;
    for (int k0 = 0; k0 < K; k0 += 16) {
        {
            const int r = tid >> 2, kk = (tid & 3) * 4;
            const float4 v = *(const float4*)(A + (size_t)(row0 + r) * lda + k0 + kk);
            As[kk][r] = v.x; As[kk + 1][r] = v.y; As[kk + 2][r] = v.z; As[kk + 3][r] = v.w;
        }
        {
            const int kk = tid >> 4, c = (tid & 15) * 4;
            float4 v = make_float4(0.f, 0.f, 0.f, 0.f);
            if (col0 + c < N) v = *(const float4*)(Bm + (size_t)(k0 + kk) * ldb + col0 + c);
            *(float4*)&Bs[kk][c] = v;
        }
        __syncthreads();
#pragma unroll
        for (int k = 0; k < 16; ++k) {
            const float4 a = *(const float4*)&As[k][ty * 4];
            const float4 b = *(const float4*)&Bs[k][tx * 4];
            const float av[4] = {a.x, a.y, a.z, a.w}, bv[4] = {b.x, b.y, b.z, b.w};
#pragma unroll
            for (int i = 0; i < 4; ++i)
#pragma unroll
                for (int j = 0; j < 4; ++j) acc[i][j] = fmaf(av[i], bv[j], acc[i][j]);
        }
        __syncthreads();
    }
    const int c = col0 + tx * 4;
    if (c < N) {
#pragma unroll
        for (int i = 0; i < 4; ++i) {
            const int r = row0 + ty * 4 + i;
            float4 o = make_float4(acc[i][0], acc[i][1], acc[i][2], acc[i][3]);
            if (X) {
                const float4 xv = *(const float4*)(X + (size_t)r * ldx + c);
                o.x += alpha * xv.x; o.y += alpha * xv.y; o.z += alpha * xv.z; o.w += alpha * xv.w;
            }
            *(float4*)(C + (size_t)r * ldc + c) = o;
        }
    }
}

__global__ void __launch_bounds__(256) k_attn_naive(const float* __restrict__ AQ, const float* __restrict__ AK, const float* __restrict__ AV,
                                                    const float* __restrict__ sink, const float* __restrict__ rel_bias, float* __restrict__ mix) {
    __shared__ float qs[4][128];
    __shared__ float ps[4][320];
    const int wave = threadIdx.x >> 6, lane = threadIdx.x & 63;
    const int item = blockIdx.x * 4 + wave;
    const int hq = item & 7, t = item >> 3, b = t / S, i = t % S, kvh = hq >> 2;
    const float* qrow = AQ + (size_t)t * 1024 + hq * 128;
    qs[wave][lane] = qrow[lane]; qs[wave][lane + 64] = qrow[lane + 64];
    __syncthreads();
    const float sk = sink[hq];
    float sc[5]; float mx = sk;
#pragma unroll
    for (int jj = 0; jj < 5; ++jj) {
        const int r = lane + 64 * jj, rel = r - 128, j = i + rel;
        float s = -INFINITY;
        if (r <= 256 && j >= 0 && j < S) {
            const float4* krow = (const float4*)(AK + (size_t)(b * S + j) * 256 + kvh * 128);
            float d = 0.f;
            for (int c = 0; c < 32; ++c) { const float4 kv = krow[c]; const float4 qv = *(const float4*)&qs[wave][c * 4]; d += qv.x * kv.x + qv.y * kv.y + qv.z * kv.z + qv.w * kv.w; }
            s = d * 0.08838834764831845f + rel_bias[t5_bucket(rel) * 8 + hq];
        }
        sc[jj] = s; mx = fmaxf(mx, s);
    }
    mx = wave_max(mx);
    float den = 0.f;
#pragma unroll
    for (int jj = 0; jj < 5; ++jj) { const float p = (sc[jj] == -INFINITY) ? 0.f : expf(sc[jj] - mx); ps[wave][lane + 64 * jj] = p; den += p; }
    den = wave_sum(den) + expf(sk - mx);
    __syncthreads();
    float o0 = 0.f, o1 = 0.f;
    for (int r = 0; r <= 256; ++r) {
        const int j = i + r - 128;
        if (j < 0 || j >= S) continue;
        const float p = ps[wave][r];
        const float* vrow = AV + (size_t)(b * S + j) * 256 + kvh * 128;
        o0 += p * vrow[lane]; o1 += p * vrow[lane + 64];
    }
    const float inv = 1.0f / den;
    mix[(size_t)t * 2048 + hq * 128 + lane] = o0 * inv;
    mix[(size_t)t * 2048 + hq * 128 + lane + 64] = o1 * inv;
}

__global__ void __launch_bounds__(128) k_dn_conv(const float* __restrict__ DQ, const float* __restrict__ DK, const float* __restrict__ DV, const float* __restrict__ conv_w,
                                                 float* __restrict__ qn, float* __restrict__ kn, float* __restrict__ vn) {
    __shared__ float red[2];
    const int g = blockIdx.x % 24, t = blockIdx.x / 24, which = g >> 3, h = g & 7, d = threadIdx.x;
    const int s = t % S;
    const float* src = which == 0 ? DQ : (which == 1 ? DK : DV);
    float* dst = which == 0 ? qn : (which == 1 ? kn : vn);
    const int ch = h * 128 + d, cch = which * 1024 + ch;
    float y = 0.f;
#pragma unroll
    for (int j = 0; j < 5; ++j) { const int sj = s + j - 2; if (sj >= 0 && sj < S) y += conv_w[j * 3072 + cch] * src[(size_t)(t + j - 2) * 1024 + ch]; }
    y = silu_f(y);
    if (which < 2) {
        float ss = wave_sum(y * y);
        if ((threadIdx.x & 63) == 0) red[threadIdx.x >> 6] = ss;
        __syncthreads();
        ss = red[0] + red[1];
        y *= 1.0f / sqrtf(ss + RMS_EPS);
    }
    dst[(size_t)t * 1024 + ch] = y;
}

__global__ void __launch_bounds__(256) k_dn_scan_naive(const float* __restrict__ qn, const float* __restrict__ kn, const float* __restrict__ vn, const float* __restrict__ BG  ,
                                                       const float* __restrict__ a_log, const float* __restrict__ dt_bias, float* __restrict__ Ofwd, float* __restrict__ Obwd) {
    __shared__ float kq[2][128];
    __shared__ float part[2][128];
    __shared__ float part2[2][128];
    const int tid = threadIdx.x, v = tid & 127, kseg = tid >> 7;
    const int dir = blockIdx.x & 1, h = (blockIdx.x >> 1) & 7, b = blockIdx.x >> 4;
    float* O = dir ? Obwd : Ofwd;
    const float negA = -expf(a_log[dir * 8 + h]), dtb = dt_bias[dir * 8 + h];
    float Sr[64];
#pragma unroll
    for (int i = 0; i < 64; ++i) Sr[i] = 0.f;
    for (int step = 0; step < S; ++step) {
        const int s = dir ? (S - 1 - step) : step;
        const size_t t = (size_t)b * S + s;
        if (kseg == 0) kq[0][v] = kn[t * 1024 + h * 128 + v]; else kq[1][v] = qn[t * 1024 + h * 128 + v];
        const float beta = sigmoid_f(BG[t * 32 + dir * 8 + h]);
        const float a = expf(negA * softplus_f(BG[t * 32 + 16 + dir * 8 + h] + dtb));
        const float vt = vn[t * 1024 + h * 128 + v];
        __syncthreads();
        float sk = 0.f;
#pragma unroll
        for (int i = 0; i < 64; ++i) sk = fmaf(kq[0][kseg * 64 + i], Sr[i], sk);
        part[kseg][v] = sk;
        __syncthreads();
        sk = part[0][v] + part[1][v];
        const float delta = beta * (vt - a * sk);
        float oo = 0.f;
#pragma unroll
        for (int i = 0; i < 64; ++i) { Sr[i] = fmaf(kq[0][kseg * 64 + i], delta, a * Sr[i]); oo = fmaf(kq[1][kseg * 64 + i], Sr[i], oo); }
        part2[kseg][v] = oo;
        __syncthreads();
        if (kseg == 0) O[t * 1024 + h * 128 + v] = (part2[0][v] + part2[1][v]) * 0.08838834764831845f;
    }
}

__global__ void __launch_bounds__(128) k_dn_combine(const float* __restrict__ Ofwd, const float* __restrict__ Obwd, const float* __restrict__ DZ, const float* __restrict__ norm_w, float* __restrict__ mix) {
    __shared__ float red[2];
    const int h = blockIdx.x & 7, t = blockIdx.x >> 3, d = threadIdx.x;
    const size_t idx = (size_t)t * 1024 + h * 128 + d;
    const float o = Ofwd[idx] + Obwd[idx];
    float ss = wave_sum(o * o);
    if ((threadIdx.x & 63) == 0) red[threadIdx.x >> 6] = ss;
    __syncthreads();
    ss = (red[0] + red[1]) * (1.0f / 128.0f);
    const float z = DZ[idx];
    mix[(size_t)t * 2048 + 1024 + h * 128 + d] = o * (1.0f / sqrtf(ss + RMS_EPS)) * norm_w[d] * silu_f(z);
}

__global__ void __launch_bounds__(256) k_ln_rows(const float* __restrict__ X, const float* __restrict__ g, const float* __restrict__ bta, float* __restrict__ Y) {
    __shared__ float red[4];
    const int t = blockIdx.x, tid = threadIdx.x;
    const float4* xr = (const float4*)(X + (size_t)t * 2048);
    const float4 a = xr[tid], c = xr[tid + 256];
    float s = (a.x + a.y) + (a.z + a.w) + (c.x + c.y) + (c.z + c.w);
    s = wave_sum(s);
    if ((tid & 63) == 0) red[tid >> 6] = s;
    __syncthreads();
    const float mean = (red[0] + red[1] + red[2] + red[3]) * (1.0f / 2048.0f);
    __syncthreads();
    const float d0 = a.x - mean, d1 = a.y - mean, d2 = a.z - mean, d3 = a.w - mean, d4 = c.x - mean, d5 = c.y - mean, d6 = c.z - mean, d7 = c.w - mean;
    float q = d0 * d0 + d1 * d1 + d2 * d2 + d3 * d3 + d4 * d4 + d5 * d5 + d6 * d6 + d7 * d7;
    q = wave_sum(q);
    if ((tid & 63) == 0) red[tid >> 6] = q;
    __syncthreads();
    const float rstd = 1.0f / sqrtf((red[0] + red[1] + red[2] + red[3]) * (1.0f / 2048.0f) + LN_EPS);
    const float4 g0 = ((const float4*)g)[tid], g1 = ((const float4*)g)[tid + 256], b0 = ((const float4*)bta)[tid], b1 = ((const float4*)bta)[tid + 256];
    float4 o0, o1;
    o0.x = d0 * rstd * g0.x + b0.x; o0.y = d1 * rstd * g0.y + b0.y; o0.z = d2 * rstd * g0.z + b0.z; o0.w = d3 * rstd * g0.w + b0.w;
    o1.x = d4 * rstd * g1.x + b1.x; o1.y = d5 * rstd * g1.y + b1.y; o1.z = d6 * rstd * g1.z + b1.z; o1.w = d7 * rstd * g1.w + b1.w;
    float4* yr = (float4*)(Y + (size_t)t * 2048);
    yr[tid] = o0; yr[tid + 256] = o1;
}

__device__ __forceinline__ void wave_argmax(float& v, int& i) {
#pragma unroll
    for (int o = 1; o < 64; o <<= 1) {
        const float ov = __shfl_xor(v, o); const int oi = __shfl_xor(i, o);
        if (ov > v || (ov == v && oi < i)) { v = ov; i = oi; }
    }
}
__global__ void __launch_bounds__(256) k_peer_select_naive(const float* __restrict__ Q  , const float* __restrict__ keys  , int* __restrict__ eidx, float* __restrict__ gate) {
    __shared__ float qs[4][256];
    __shared__ float svs[4][2][16];
    __shared__ int sis[4][2][16];
    const int wave = threadIdx.x >> 6, lane = threadIdx.x & 63;
    const int item = blockIdx.x * 4 + wave, hd = item & 7, t = item >> 3;
    const float* qrow = Q + (size_t)t * 2048 + hd * 256;
#pragma unroll
    for (int j = 0; j < 4; ++j) qs[wave][lane + 64 * j] = qrow[lane + 64 * j];
    __syncthreads();
    float sc[2][2];
#pragma unroll
    for (int p = 0; p < 2; ++p)
#pragma unroll
        for (int kk = 0; kk < 2; ++kk) {
            const float4* kr = (const float4*)(keys + ((size_t)p * 128 + lane + 64 * kk) * 128);
            float d = 0.f;
            for (int c = 0; c < 32; ++c) { const float4 kv = kr[c]; const float4 qv = *(const float4*)&qs[wave][p * 128 + c * 4]; d += qv.x * kv.x + qv.y * kv.y + qv.z * kv.z + qv.w * kv.w; }
            sc[p][kk] = d;
        }
#pragma unroll
    for (int p = 0; p < 2; ++p) {
        for (int r = 0; r < 16; ++r) {
            float v; int i;
            if (sc[p][0] >= sc[p][1]) { v = sc[p][0]; i = lane; } else { v = sc[p][1]; i = lane + 64; }
            wave_argmax(v, i);
            if (lane == 0) { svs[wave][p][r] = v; sis[wave][p][r] = i; }
            if (i == lane) sc[p][0] = -INFINITY;
            if (i == lane + 64) sc[p][1] = -INFINITY;
        }
    }
    __syncthreads();
    float cs[4];
#pragma unroll
    for (int j = 0; j < 4; ++j) { const int c = lane + 64 * j; cs[j] = svs[wave][0][c >> 4] + svs[wave][1][c & 15]; }
    float tops = 0.f; int topc = 0;
    for (int r = 0; r < 16; ++r) {
        float v = cs[0]; int i = lane;
#pragma unroll
        for (int j = 1; j < 4; ++j) if (cs[j] > v) { v = cs[j]; i = lane + 64 * j; }
        wave_argmax(v, i);
        if (lane == r) { tops = v; topc = i; }
#pragma unroll
        for (int j = 0; j < 4; ++j) if (i == lane + 64 * j) cs[j] = -INFINITY;
    }
    float m = (lane < 16) ? tops : -INFINITY;
    m = wave_max(m);
    const float e = (lane < 16) ? expf(tops - m) : 0.f;
    const float den = wave_sum(e);
    if (lane < 16) {
        const int ex = sis[wave][0][topc >> 4] * 128 + sis[wave][1][topc & 15];
        eidx[(size_t)t * 128 + hd * 16 + lane] = ex;
        gate[(size_t)t * 128 + hd * 16 + lane] = e / den;
    }
}

__global__ void __launch_bounds__(256) k_peer_gather_naive(const float* __restrict__ H, const int* __restrict__ eidx, const float* __restrict__ gate, const float* __restrict__ U, const float* __restrict__ V,
                                                           const float* __restrict__ g2, const float* __restrict__ b2, float* __restrict__ out) {
    const int wave = threadIdx.x >> 6, lane = threadIdx.x & 63;
    const int t = blockIdx.x * 4 + wave;
    const float4* hr = (const float4*)(H + (size_t)t * 2048);
    float4 hv[8], acc[8];
#pragma unroll
    for (int j = 0; j < 8; ++j) { hv[j] = hr[lane + 64 * j]; acc[j] = make_float4(0.f, 0.f, 0.f, 0.f); }
    for (int p = 0; p < 128; ++p) {
        const int e = eidx[(size_t)t * 128 + p];
        const float gt = gate[(size_t)t * 128 + p];
        const float4* ur = (const float4*)(U + (size_t)e * 2048);
        float d = 0.f;
#pragma unroll
        for (int j = 0; j < 8; ++j) { const float4 u = ur[lane + 64 * j]; d += u.x * hv[j].x + u.y * hv[j].y + u.z * hv[j].z + u.w * hv[j].w; }
        d = wave_sum(d);
        const float act = 0.5f * d * (1.0f + erff(d * 0.7071067811865476f));
        const float cf = act * gt;
        const float4* vr = (const float4*)(V + (size_t)e * 2048);
#pragma unroll
        for (int j = 0; j < 8; ++j) { const float4 vv = vr[lane + 64 * j]; acc[j].x += cf * vv.x; acc[j].y += cf * vv.y; acc[j].z += cf * vv.z; acc[j].w += cf * vv.w; }
    }
    float s = 0.f;
#pragma unroll
    for (int j = 0; j < 8; ++j) { acc[j].x += ALPHA * hv[j].x; acc[j].y += ALPHA * hv[j].y; acc[j].z += ALPHA * hv[j].z; acc[j].w += ALPHA * hv[j].w; s += (acc[j].x + acc[j].y) + (acc[j].z + acc[j].w); }
    const float mean = wave_sum(s) * (1.0f / 2048.0f);
    float q = 0.f;
#pragma unroll
    for (int j = 0; j < 8; ++j) { acc[j].x -= mean; acc[j].y -= mean; acc[j].z -= mean; acc[j].w -= mean; q += acc[j].x * acc[j].x + acc[j].y * acc[j].y + acc[j].z * acc[j].z + acc[j].w * acc[j].w; }
    const float rstd = 1.0f / sqrtf(wave_sum(q) * (1.0f / 2048.0f) + LN_EPS);
    float4* orow = (float4*)(out + (size_t)t * 2048);
#pragma unroll
    for (int j = 0; j < 8; ++j) {
        const float4 g = ((const float4*)g2)[lane + 64 * j], bb = ((const float4*)b2)[lane + 64 * j];
        float4 o; o.x = acc[j].x * rstd * g.x + bb.x; o.y = acc[j].y * rstd * g.y + bb.y; o.z = acc[j].z * rstd * g.z + bb.z; o.w = acc[j].w * rstd * g.w + bb.w;
        orow[lane + 64 * j] = o;
    }
}
}

extern "C" void kernel_launch(void* const* d_in, const int* in_sizes, int n_in, void* d_out, int out_size, void* d_ws, size_t ws_size, hipStream_t stream) {
    const float* x = (const float*)d_in[0];
    const float* w_in = (const float*)d_in[1];
    const float* conv_w = (const float*)d_in[2];
    const float* a_log = (const float*)d_in[3];
    const float* dt_bias = (const float*)d_in[4];
    const float* dn_norm_w = (const float*)d_in[5];
    const float* attn_sink = (const float*)d_in[6];
    const float* rel_bias = (const float*)d_in[7];
    const float* w_out = (const float*)d_in[8];
    const float* ln1_g = (const float*)d_in[9];
    const float* ln1_b = (const float*)d_in[10];
    const float* peer_wq = (const float*)d_in[11];
    const float* peer_keys = (const float*)d_in[12];
    const float* peer_u = (const float*)d_in[13];
    const float* peer_v = (const float*)d_in[14];
    const float* ln2_g = (const float*)d_in[15];
    const float* ln2_b = (const float*)d_in[16];
    float* out = (float*)d_out;
    char* ws = (char*)d_ws;
    if (n_in != 17 || out_size != T * D || ws_size < 500 * MB) { fprintf(stderr, "kernel_launch: unexpected sizes n_in %d out %d ws %zu\n", n_in, out_size, ws_size); return; }
    float* AQ = (float*)(ws + 0 * MB);
    float* AK = (float*)(ws + 64 * MB);
    float* AV = (float*)(ws + 80 * MB);
    float* DQ = (float*)(ws + 96 * MB);
    float* DK = (float*)(ws + 160 * MB);
    float* DV = (float*)(ws + 224 * MB);
    float* DZ = (float*)(ws + 288 * MB);
    float* BG = (float*)(ws + 352 * MB);
    float* KN = (float*)(ws + 356 * MB);
    float* VN = (float*)(ws + 420 * MB);
    float* QN = AQ; float* OF = DQ; float* OB = DK;
    float* MIX = out;
    float* PRE = (float*)(ws + 0 * MB);
    float* H = (float*)(ws + 128 * MB);
    float* QP = (float*)(ws + 256 * MB);
    int* EIDX = (int*)(ws + 384 * MB);
    float* GATE = (float*)(ws + 392 * MB);

    auto gemm = [&](const float* A, int lda, const float* Bm, int ldb, float* C, int ldc, int M, int N, int K, const float* X, int ldx, float alpha) {
        const int ntn = (N + 63) / 64;
        hipLaunchKernelGGL(k_gemm_f32, dim3((M / 64) * ntn), dim3(256), 0, stream, A, lda, Bm, ldb, C, ldc, M, N, K, X, ldx, alpha);
    };
    gemm(x, D, w_in + O_AQ, INW, AQ, 1024, T, 1024, D, nullptr, 0, 0.f);
    gemm(x, D, w_in + O_AK, INW, AK, 256, T, 256, D, nullptr, 0, 0.f);
    gemm(x, D, w_in + O_AV, INW, AV, 256, T, 256, D, nullptr, 0, 0.f);
    gemm(x, D, w_in + O_DQ, INW, DQ, 1024, T, 1024, D, nullptr, 0, 0.f);
    gemm(x, D, w_in + O_DK, INW, DK, 1024, T, 1024, D, nullptr, 0, 0.f);
    gemm(x, D, w_in + O_DV, INW, DV, 1024, T, 1024, D, nullptr, 0, 0.f);
    gemm(x, D, w_in + O_DZ, INW, DZ, 1024, T, 1024, D, nullptr, 0, 0.f);
    gemm(x, D, w_in + O_DB, INW, BG, 32, T, 32, D, nullptr, 0, 0.f);
    hipLaunchKernelGGL(k_attn_naive, dim3(T * 8 / 4), dim3(256), 0, stream, AQ, AK, AV, attn_sink, rel_bias, MIX);
    hipLaunchKernelGGL(k_dn_conv, dim3(T * 24), dim3(128), 0, stream, DQ, DK, DV, conv_w, QN, KN, VN);
    hipLaunchKernelGGL(k_dn_scan_naive, dim3(64), dim3(256), 0, stream, QN, KN, VN, BG, a_log, dt_bias, OF, OB);
    hipLaunchKernelGGL(k_dn_combine, dim3(T * 8), dim3(128), 0, stream, OF, OB, DZ, dn_norm_w, MIX);
    gemm(MIX, D, w_out, D, PRE, D, T, D, D, x, D, ALPHA);
    hipLaunchKernelGGL(k_ln_rows, dim3(T), dim3(256), 0, stream, PRE, ln1_g, ln1_b, H);
    gemm(H, D, peer_wq, D, QP, D, T, D, D, nullptr, 0, 0.f);
    hipLaunchKernelGGL(k_peer_select_naive, dim3(T * 8 / 4), dim3(256), 0, stream, QP, peer_keys, EIDX, GATE);
    hipLaunchKernelGGL(k_peer_gather_naive, dim3(T / 4), dim3(256), 0, stream, H, EIDX, GATE, peer_u, peer_v, ln2_g, ln2_b, out);
}
```

```cpp
#include <hip/hip_runtime.h>
#include <hip/hip_cooperative_groups.h>
#include <cstdio>
#include <cstdint>
#include <cmath>
#include <cstring>

namespace {
namespace cg = cooperative_groups;
#define LAS __attribute__((address_space(3)))
typedef unsigned short bf16_t;
typedef short bf16x8 __attribute__((ext_vector_type(8)));
typedef float f32x4 __attribute__((ext_vector_type(4)));
typedef float f32x2 __attribute__((ext_vector_type(2)));
typedef unsigned u32x4 __attribute__((ext_vector_type(4)));
typedef unsigned u32x2 __attribute__((ext_vector_type(2)));

constexpr int D = 2048, NB = 4, S = 4096, T = NB * S;
constexpr int INW = 5664;
constexpr float ALPHA = 1.189207115002721f;
constexpr float LN_EPS = 1e-5f, RMS_EPS = 1e-6f;
constexpr size_t MB = 1024ull * 1024ull;
constexpr int NTHREADS = 512;
constexpr int LDS_BYTES = 134 * 1024;

__device__ __forceinline__ float wave_sum(float v) {
#pragma unroll
    for (int o = 1; o < 64; o <<= 1) v += __shfl_xor(v, o);
    return v;
}
__device__ __forceinline__ float wave_max(float v) {
#pragma unroll
    for (int o = 1; o < 64; o <<= 1) v = fmaxf(v, __shfl_xor(v, o));
    return v;
}
__device__ __forceinline__ float silu_f(float x) { return x * __builtin_amdgcn_rcpf(1.0f + __builtin_amdgcn_exp2f(-1.4426950408889634f * x)); }
__device__ __forceinline__ float sigmoid_f(float x) { return 1.0f / (1.0f + expf(-x)); }
__device__ __forceinline__ float softplus_f(float x) { return fmaxf(x, 0.f) + log1pf(expf(-fabsf(x))); }
__device__ __forceinline__ float bf2f(bf16_t v) { return __uint_as_float(((unsigned)v) << 16); }
__device__ __forceinline__ float ldf(const float* p) { return *p; }
__device__ __forceinline__ float ldf(const bf16_t* p) { return bf2f(*p); }
typedef __bf16 bf16x2_t __attribute__((ext_vector_type(2)));
__device__ __forceinline__ unsigned cvt_pk_bf16(float lo, float hi) { const f32x2 v = {lo, hi}; return __builtin_bit_cast(unsigned, __builtin_convertvector(v, bf16x2_t)); }
__device__ __forceinline__ bf16_t f2bf(float f) { return (bf16_t)(cvt_pk_bf16(f, 0.f) & 0xffffu); }
__device__ __forceinline__ int t5_bucket(int rel) {
    int n = rel < 0 ? -rel : rel;
    int v;
    if (n < 8) v = n; else if (n < 12) v = 8; else if (n < 16) v = 9; else if (n < 23) v = 10; else if (n < 32) v = 11;
    else if (n < 46) v = 12; else if (n < 64) v = 13; else if (n < 91) v = 14; else v = 15;
    return v + (rel > 0 ? 16 : 0);
}

namespace pg8 {
constexpr int BM = 256, BK = 64, HALF = 128, HTB = HALF * BK * 2, STAGE_BYTES = 8 * HTB, NXCD = 8, WGM = 8;
__host__ __device__ __forceinline__ int lds_byte(int r, int c) { const int st = (r >> 4) * 2 + (c >> 5), rr = r & 15, cc = c & 31, ob = rr * 64 + cc * 2; return st * 1024 + (ob ^ (((ob >> 9) & 1) << 5)); }
__host__ __device__ __forceinline__ void stage_rc(int b, int& R, int& C) { const int st = b / 1024, sb = b % 1024, swz = sb ^ (((sb >> 9) & 1) << 5); R = (st >> 1) * 16 + swz / 64; C = (st & 1) * 32 + (swz % 64) / 2; }
__host__ __device__ __forceinline__ int perm32(int rho) { const int n = rho >> 4, i = rho & 15; return 8 * (i >> 2) + 4 * n + (i & 3); }
struct Unit { int pm, pn; };
struct Gemm { const bf16_t* A; const bf16_t* Bt; int K; };
struct StaticOrder {
    int nM, nN, nwg, G, c;
    __device__ void init(int nM_, int nN_, int G_, int c_) { nM = nM_; nN = nN_; nwg = nM * nN; G = G_; c = c_; }
    __device__ bool next(int i, Unit& u) const {
        const long L = (long)i * G + c; if (L >= nwg) return false;
        int wgid = (int)L; { const int q = nwg / NXCD, r = nwg % NXCD, xcd = wgid % NXCD, off = wgid / NXCD; wgid = (xcd < r ? xcd * (q + 1) : r * (q + 1) + (xcd - r) * q) + off; }
        const int nig = WGM * nN, gid = wgid / nig, fm = gid * WGM, gsz = (nM - fm) < WGM ? (nM - fm) : WGM;
        u.pm = fm + ((wgid % nig) % gsz); u.pn = (wgid % nig) / gsz; return true;
    }
};
struct ProjOrder {
    StaticOrder so; int G, c;
    __device__ void init(int G_, int c_) { so.init(64, 22, G_, c_); G = G_; c = c_; }
    __device__ bool next(int i, Unit& u) const {
        const long L = (long)i * G + c;
        if (L < 1408) { so.next(i, u); u.pn = 64 + (u.pn < 5 ? u.pn : u.pn + 1); return true; }
        if (L < 1472) { u.pm = 69; u.pn = (int)(L - 1408); return true; }
        return false;
    }
};

struct EpiProj {
    static constexpr bool PERM = true, HAS_PRE = false;
    bf16_t *AQ, *AK, *AVT, *DQ, *DK, *DV, *DZ; float* BG;
    __device__ __forceinline__ void operator()(const f32x4 (&acc)[2][2][4][2], const Unit& u, int wr, int wc, int fr, int fq) const {
        bf16_t* base; int ldc; int colt; int rowt;
        if (u.pm == 69) { base = AVT; ldc = T; colt = u.pn * BM; rowt = 0; }
        else {
            rowt = u.pm * BM; const int wt = u.pn - 64;
            if (wt == 22) {
                if (wc == 0) {
#pragma unroll
                    for (int ai = 0; ai < 2; ++ai)
#pragma unroll
                        for (int m = 0; m < 4; ++m) { float* rowp = BG + (size_t)(rowt + ai * HALF + wr * 64 + m * 16 + fr) * 32 + 8 * fq;
                            *(f32x4*)(rowp) = acc[ai][0][m][0]; *(f32x4*)(rowp + 4) = acc[ai][0][m][1]; }
                }
                return;
            }
            if (wt < 4) { base = AQ; ldc = 1024; colt = wt * 256; }
            else if (wt == 4) { base = AK; ldc = 256; colt = 0; }
            else if (wt < 10) { base = DQ; ldc = 1024; colt = (wt - 6) * 256; }
            else if (wt < 14) { base = DK; ldc = 1024; colt = (wt - 10) * 256; }
            else if (wt < 18) { base = DV; ldc = 1024; colt = (wt - 14) * 256; }
            else { base = DZ; ldc = 1024; colt = (wt - 18) * 256; }
        }
        const int row0 = rowt + wr * 64 + fr, col0 = colt + wc * 32 + 8 * fq;
#pragma unroll
        for (int ai = 0; ai < 2; ++ai)
#pragma unroll
            for (int m = 0; m < 4; ++m) { bf16_t* rowp = base + (size_t)(row0 + ai * HALF + m * 16) * ldc + col0;
#pragma unroll
                for (int bj = 0; bj < 2; ++bj) { const f32x4 v0 = acc[ai][bj][m][0], v1 = acc[ai][bj][m][1];
                    u32x4 w; w.x = cvt_pk_bf16(v0[0], v0[1]); w.y = cvt_pk_bf16(v0[2], v0[3]); w.z = cvt_pk_bf16(v1[0], v1[1]); w.w = cvt_pk_bf16(v1[2], v1[3]);
                    *(u32x4*)(rowp + bj * HALF) = w; } }
    }
};
struct EpiBf16 {
    static constexpr bool PERM = true, HAS_PRE = false;
    bf16_t* O; int ldc;
    __device__ __forceinline__ void operator()(const f32x4 (&acc)[2][2][4][2], const Unit& u, int wr, int wc, int fr, int fq) const {
        const int row0 = u.pm * BM + wr * 64 + fr, col0 = u.pn * BM + wc * 32 + 8 * fq;
#pragma unroll
        for (int ai = 0; ai < 2; ++ai)
#pragma unroll
            for (int m = 0; m < 4; ++m) { bf16_t* rowp = O + (size_t)(row0 + ai * HALF + m * 16) * ldc + col0;
#pragma unroll
                for (int bj = 0; bj < 2; ++bj) { const f32x4 v0 = acc[ai][bj][m][0], v1 = acc[ai][bj][m][1];
                    u32x4 w; w.x = cvt_pk_bf16(v0[0], v0[1]); w.y = cvt_pk_bf16(v0[2], v0[3]); w.z = cvt_pk_bf16(v1[0], v1[1]); w.w = cvt_pk_bf16(v1[2], v1[3]);
                    *(u32x4*)(rowp + bj * HALF) = w; } }
    }
};
struct EpiResF32 {
    static constexpr bool PERM = false, HAS_PRE = false;
    float* C; const float* X; int ldc; float alpha;
    __device__ __forceinline__ void operator()(const f32x4 (&acc)[2][2][4][2], const Unit& u, int wr, int wc, int fr, int fq) const {
        const int row0 = u.pm * BM + wr * 64 + fr, col0 = u.pn * BM + wc * 32 + 4 * fq;
        const float* __restrict__ Xr = X; float* __restrict__ Cr = C;
#pragma unroll
        for (int ai = 0; ai < 2; ++ai)
#pragma unroll
            for (int mp = 0; mp < 2; ++mp) {
                f32x4 xv[2][2][2];
#pragma unroll
                for (int mq = 0; mq < 2; ++mq) { const size_t off = (size_t)(row0 + ai * HALF + (2 * mp + mq) * 16) * ldc + col0;
#pragma unroll
                    for (int bj = 0; bj < 2; ++bj)
#pragma unroll
                        for (int n = 0; n < 2; ++n) xv[mq][bj][n] = __builtin_nontemporal_load((const f32x4*)(Xr + off + bj * HALF + n * 16)); }
#pragma unroll
                for (int mq = 0; mq < 2; ++mq) { const size_t off = (size_t)(row0 + ai * HALF + (2 * mp + mq) * 16) * ldc + col0;
#pragma unroll
                    for (int bj = 0; bj < 2; ++bj)
#pragma unroll
                        for (int n = 0; n < 2; ++n) *(f32x4*)(Cr + off + bj * HALF + n * 16) = acc[ai][bj][2 * mp + mq][n] + alpha * xv[mq][bj][n]; }
                asm volatile("" ::: "memory"); }
    }
};

struct EpiResBf16 {
    static constexpr bool PERM = true, HAS_PRE = false;
    bf16_t* O; const float* X; int ldc; float alpha; float* PART;
    __device__ __forceinline__ void operator()(const f32x4 (&acc)[2][2][4][2], const Unit& u, int wr, int wc, int fr, int fq) const {
        const int row0 = u.pm * BM + wr * 64 + fr, col0 = u.pn * BM + wc * 32 + 8 * fq;
        const float* __restrict__ Xr = X; bf16_t* __restrict__ Or = O;
#pragma unroll
        for (int ai = 0; ai < 2; ++ai)
#pragma unroll
            for (int mp = 0; mp < 2; ++mp) {
                f32x4 xv[2][2][2];
#pragma unroll
                for (int mq = 0; mq < 2; ++mq) { const size_t off = (size_t)(row0 + ai * HALF + (2 * mp + mq) * 16) * ldc + col0;
#pragma unroll
                    for (int bj = 0; bj < 2; ++bj) { xv[mq][bj][0] = __builtin_nontemporal_load((const f32x4*)(Xr + off + bj * HALF)); xv[mq][bj][1] = __builtin_nontemporal_load((const f32x4*)(Xr + off + bj * HALF + 4)); } }
#pragma unroll
                for (int mq = 0; mq < 2; ++mq) { const int row = row0 + ai * HALF + (2 * mp + mq) * 16; const size_t off = (size_t)row * ldc + col0;
                    float s1 = 0.f, s2 = 0.f;
#pragma unroll
                    for (int bj = 0; bj < 2; ++bj) { const f32x4 v0 = acc[ai][bj][2 * mp + mq][0] + alpha * xv[mq][bj][0], v1 = acc[ai][bj][2 * mp + mq][1] + alpha * xv[mq][bj][1];
                        u32x4 w; w.x = cvt_pk_bf16(v0[0], v0[1]); w.y = cvt_pk_bf16(v0[2], v0[3]); w.z = cvt_pk_bf16(v1[0], v1[1]); w.w = cvt_pk_bf16(v1[2], v1[3]);
                        *(u32x4*)(Or + off + bj * HALF) = w;
#pragma unroll
                        for (int e = 0; e < 4; ++e) { const float lo = __uint_as_float(w[e] << 16), hi = __uint_as_float(w[e] & 0xffff0000u); s1 += lo + hi; s2 = fmaf(lo, lo, s2); s2 = fmaf(hi, hi, s2); } }
                    s1 += __shfl_xor(s1, 16); s1 += __shfl_xor(s1, 32); s2 += __shfl_xor(s2, 16); s2 += __shfl_xor(s2, 32);
                    if (fq == 0) *(f32x2*)(PART + (size_t)row * 64 + (u.pn * 4 + wc) * 2) = (f32x2){s1, s2}; }
                asm volatile("" ::: "memory"); }
    }
};
struct EpiLnQ {
    static constexpr bool PERM = true, HAS_PRE = true;
    bf16_t* O; int ldc; const float* PART; const float* CS; const float* BW;
    __device__ __forceinline__ void pre(LAS unsigned char* lds, const Unit& u, int ui) const {
        int tid = threadIdx.x; asm volatile("" : "+v"(tid));
        LAS float* tab = (LAS float*)(lds + STAGE_BYTES + (ui & 1) * 2048);
        if (tid < 256) {
            const f32x4* pp = (const f32x4*)(PART + (size_t)(u.pm * BM + tid) * 64);
            float s1 = 0.f, s2 = 0.f;
#pragma unroll
            for (int i = 0; i < 16; ++i) { const f32x4 v = pp[i]; s1 += v[0] + v[2]; s2 += v[1] + v[3]; }
            const float mean = s1 * (1.0f / 2048.0f), var = fmaxf(s2 * (1.0f / 2048.0f) - mean * mean, 0.f);
            tab[2 * tid] = mean; tab[2 * tid + 1] = 1.0f / sqrtf(var + 1e-5f);
        }
        asm volatile("s_waitcnt lgkmcnt(0)" ::: "memory"); __builtin_amdgcn_s_barrier(); asm volatile("" ::: "memory");
    }
    __device__ __forceinline__ void run(LAS unsigned char* lds, int ui, const f32x4 (&acc)[2][2][4][2], const Unit& u, int wr, int wc, int fr, int fq) const {
        const LAS f32x2* tab = (const LAS f32x2*)(lds + STAGE_BYTES + (ui & 1) * 2048);
        const int rl0 = wr * 64 + fr, col0 = u.pn * BM + wc * 32 + 8 * fq;
        f32x4 cs[2][2], bw[2][2];
#pragma unroll
        for (int bj = 0; bj < 2; ++bj)
#pragma unroll
            for (int n = 0; n < 2; ++n) { cs[bj][n] = *(const f32x4*)(CS + col0 + bj * HALF + 4 * n); bw[bj][n] = *(const f32x4*)(BW + col0 + bj * HALF + 4 * n); }
#pragma unroll
        for (int ai = 0; ai < 2; ++ai)
#pragma unroll
            for (int m = 0; m < 4; ++m) { const int rl = rl0 + ai * HALF + m * 16; const f32x2 st = tab[rl]; bf16_t* rowp = O + (size_t)(u.pm * BM + rl) * ldc + col0;
#pragma unroll
                for (int bj = 0; bj < 2; ++bj) { const f32x4 v0 = (acc[ai][bj][m][0] - st.x * cs[bj][0]) * st.y + bw[bj][0], v1 = (acc[ai][bj][m][1] - st.x * cs[bj][1]) * st.y + bw[bj][1];
                    u32x4 w; w.x = cvt_pk_bf16(v0[0], v0[1]); w.y = cvt_pk_bf16(v0[2], v0[3]); w.z = cvt_pk_bf16(v1[0], v1[1]); w.w = cvt_pk_bf16(v1[2], v1[3]);
                    *(u32x4*)(rowp + bj * HALF) = w; } }
    }
};

template <class Epi, class Sched>
__device__ __forceinline__ void gemm_phase(LAS unsigned char* lds, const Gemm g, const Sched& S, const Epi& E) {
    int tid_ = threadIdx.x; asm volatile("" : "+v"(tid_) :: "memory");
    const int tid = tid_, wid = __builtin_amdgcn_readfirstlane(tid >> 6), lane = tid & 63, wr = wid >> 2, wc = wid & 3, fr = lane & 15, fq = lane >> 4;
    const int K = g.K, nt = K / BK;
    unsigned voffA[2], voffB[2];
#pragma unroll
    for (int i = 0; i < 2; ++i) { int R, C; stage_rc(tid * 16 + i * 8192, R, C); const int Rb = Epi::PERM ? ((R & ~31) + perm32(R & 31)) : R;
        voffA[i] = (unsigned)(R * K + C) * 2u; voffB[i] = (unsigned)(Rb * K + C) * 2u; }
    const size_t kstep = (size_t)(BK * 2);
    const size_t hstep = (size_t)HALF * K * 2;
    const size_t tstep = 2 * hstep;
    const unsigned ldsw = (unsigned)wid * 1024u;
    const int aoff = lds_byte(wr * 64 + fr, fq * 8), boff = lds_byte(wc * 32 + fr, fq * 8);
#define PG8_SA(b, h) (((b) * 2 + (h)) * HTB)
#define PG8_SB(b, h) ((4 + (b) * 2 + (h)) * HTB)
#define PG8_STAGE(bufoff, gbase, voff) do { _Pragma("unroll") for (int _i = 0; _i < 2; ++_i) \
        __builtin_amdgcn_global_load_lds((const unsigned*)((const char*)(gbase) + (voff)[_i]), (LAS unsigned*)(lds + (bufoff) + ldsw + _i * 8192), 16, 0, 0); } while (0)
#define PG8_LDA(dst, b, h) do { _Pragma("unroll") for (int m = 0; m < 4; ++m) _Pragma("unroll") for (int k = 0; k < 2; ++k) dst[m][k] = *(const LAS bf16x8*)(lds + PG8_SA(b, h) + aoff + m * 2048 + k * 1024); } while (0)
#define PG8_LDB(dst, b, h) do { _Pragma("unroll") for (int n = 0; n < 2; ++n) _Pragma("unroll") for (int k = 0; k < 2; ++k) dst[n][k] = *(const LAS bf16x8*)(lds + PG8_SB(b, h) + boff + n * 2048 + k * 1024); } while (0)
#define PG8_MMA(ai, bj, At, Bt) do { __builtin_amdgcn_s_setprio(1); _Pragma("unroll") for (int m = 0; m < 4; ++m) _Pragma("unroll") for (int n = 0; n < 2; ++n) _Pragma("unroll") for (int k = 0; k < 2; ++k) \
        acc[ai][bj][m][n] = __builtin_amdgcn_mfma_f32_16x16x32_bf16(Bt[n][k], At[m][k], acc[ai][bj][m][n], 0, 0, 0); __builtin_amdgcn_s_setprio(0); } while (0)
#define PG8_WAIT_V(n) asm volatile("s_waitcnt vmcnt(" #n ")" ::: "memory")
#define PG8_WAIT_L(n) asm volatile("s_waitcnt lgkmcnt(" #n ")" ::: "memory")
#define PG8_BAR __builtin_amdgcn_s_barrier()
#define PG8_SCHED __builtin_amdgcn_sched_barrier(0)
    Unit cur, nxt; int ui = 0;
    if (!S.next(0, cur)) return;
    f32x4 acc[2][2][4][2];
#pragma unroll
    for (int a = 0; a < 2; ++a)
#pragma unroll
        for (int b = 0; b < 2; ++b)
#pragma unroll
            for (int m = 0; m < 4; ++m)
#pragma unroll
                for (int n = 0; n < 2; ++n) acc[a][b][m][n] = (f32x4){0.f, 0.f, 0.f, 0.f};
    bf16x8 At[4][2], B0[2][2], B1[2][2];
    const char* cA = (const char*)g.A + (size_t)cur.pm * tstep; const char* cB = (const char*)g.Bt + (size_t)cur.pn * tstep;
    PG8_STAGE(PG8_SB(0, 0), cB, voffB); PG8_STAGE(PG8_SA(0, 0), cA, voffA); PG8_STAGE(PG8_SB(0, 1), cB + hstep, voffB); PG8_STAGE(PG8_SA(0, 1), cA + hstep, voffA);
    if (wr == 1) PG8_BAR;
    PG8_WAIT_V(4); PG8_BAR;
    PG8_STAGE(PG8_SB(1, 0), cB + kstep, voffB); PG8_STAGE(PG8_SA(1, 0), cA + kstep, voffA); PG8_STAGE(PG8_SB(1, 1), cB + hstep + kstep, voffB);
    PG8_WAIT_V(6); PG8_BAR;
    for (;;) {
        const bool has_next = S.next(ui + 1, nxt);
        const char* nA = has_next ? (const char*)g.A + (size_t)nxt.pm * tstep : cA; const char* nB = has_next ? (const char*)g.Bt + (size_t)nxt.pn * tstep : cB;
        for (int t = 0; t < nt; t += 2) {
            const bool last = (t == nt - 2);
            const char* a1 = cA + (size_t)(t + 1) * kstep;
            const char* a2 = last ? nA : cA + (size_t)(t + 2) * kstep; const char* b2 = last ? nB : cB + (size_t)(t + 2) * kstep;
            const char* a3 = a2 + kstep; const char* b3 = b2 + kstep;
            PG8_LDB(B0, 0, 0); PG8_SCHED; PG8_LDA(At, 0, 0); PG8_STAGE(PG8_SA(1, 1), a1 + hstep, voffA);
            PG8_WAIT_L(8); PG8_BAR; PG8_WAIT_L(0); PG8_MMA(0, 0, At, B0); PG8_BAR; PG8_SCHED;
            PG8_LDB(B1, 0, 1); PG8_STAGE(PG8_SB(0, 0), b2, voffB);
            PG8_BAR; PG8_WAIT_L(0); PG8_MMA(0, 1, At, B1); PG8_BAR;
            PG8_LDA(At, 0, 1); PG8_STAGE(PG8_SA(0, 0), a2, voffA);
            PG8_BAR; PG8_WAIT_L(0); PG8_MMA(1, 0, At, B0); PG8_BAR; PG8_SCHED;
            PG8_STAGE(PG8_SB(0, 1), b2 + hstep, voffB);
            PG8_WAIT_V(6); PG8_BAR; PG8_MMA(1, 1, At, B1); PG8_BAR;
            PG8_LDB(B0, 1, 0); PG8_SCHED; PG8_LDA(At, 1, 0); PG8_STAGE(PG8_SA(0, 1), a2 + hstep, voffA);
            PG8_WAIT_L(8); PG8_BAR; PG8_WAIT_L(0); PG8_MMA(0, 0, At, B0); PG8_BAR; PG8_SCHED;
            PG8_LDB(B1, 1, 1); PG8_STAGE(PG8_SB(1, 0), b3, voffB);
            PG8_BAR; PG8_WAIT_L(0); PG8_MMA(0, 1, At, B1); PG8_BAR;
            PG8_LDA(At, 1, 1); PG8_STAGE(PG8_SA(1, 0), a3, voffA);
            PG8_BAR; PG8_WAIT_L(0); PG8_MMA(1, 0, At, B0); PG8_BAR; PG8_SCHED;
            PG8_STAGE(PG8_SB(1, 1), b3 + hstep, voffB);
            PG8_WAIT_V(6); PG8_BAR; PG8_MMA(1, 1, At, B1); PG8_BAR;
        }
        if constexpr (Epi::HAS_PRE) { E.pre(lds, cur, ui); E.run(lds, ui, acc, cur, wr, wc, fr, fq); }
        else E(acc, cur, wr, wc, fr, fq);
        if (!has_next) break;
#pragma unroll
        for (int a = 0; a < 2; ++a)
#pragma unroll
            for (int b = 0; b < 2; ++b)
#pragma unroll
                for (int m = 0; m < 4; ++m)
#pragma unroll
                    for (int n = 0; n < 2; ++n) acc[a][b][m][n] = (f32x4){0.f, 0.f, 0.f, 0.f};
        cur = nxt; cA = nA; cB = nB; ++ui;
    }
    PG8_WAIT_V(0);
    if (wr == 0) PG8_BAR;
    PG8_BAR;
#undef PG8_SA
#undef PG8_SB
#undef PG8_STAGE
#undef PG8_LDA
#undef PG8_LDB
#undef PG8_MMA
#undef PG8_WAIT_V
#undef PG8_WAIT_L
#undef PG8_BAR
#undef PG8_SCHED
}
}

#define XB_TMO      128
#define XB_XCNT(j)  (256  + 64 * (j))
#define XB_XSUB(j)  (1280 + 64 * (j))
#define XB_XGEN(j)  (2304 + 64 * (j))
#define XB_TOP      3328
#define XB_TOPGEN   3392
#define XCD_BAR_WORDS 3456
#define XB_SPIN_CAP (1u << 22)
__device__ __forceinline__ unsigned xb_ld(unsigned* p)              { return __hip_atomic_load(p, __ATOMIC_RELAXED, __HIP_MEMORY_SCOPE_AGENT); }
__device__ __forceinline__ unsigned xb_add(unsigned* p, unsigned v) { return __hip_atomic_fetch_add(p, v, __ATOMIC_RELAXED, __HIP_MEMORY_SCOPE_AGENT); }
__device__ __forceinline__ unsigned xb_xcc_id() { return (unsigned)__builtin_amdgcn_s_getreg((3 << 11) | 20) & 0xFu; }
#define XB_SPIN(cond, bar) do { unsigned _sp = 0; while (cond) { __builtin_amdgcn_s_sleep(1); \
    if ((++_sp & 255u) == 0u) { if (xb_ld(&(bar)[XB_TMO])) break; if (_sp > XB_SPIN_CAP) { atomicAdd(&(bar)[XB_TMO], 1u); break; } } } } while (0)
struct XcdBarrier { unsigned* bar; unsigned x; volatile LAS unsigned* st; };
__device__ __forceinline__ XcdBarrier xcd_barrier_post(unsigned* bar, volatile LAS unsigned* st) {
    XcdBarrier b; b.bar = bar; b.x = xb_xcc_id(); b.st = st;
    if (threadIdx.x == 0) (void)xb_add(&bar[XB_XCNT(b.x)], 1u);
    return b;
}
__device__ __forceinline__ void xcd_barrier_complete(unsigned* bar, unsigned x, unsigned& nloc, unsigned& nx) {
    const unsigned G = gridDim.x * gridDim.y * gridDim.z;
    unsigned sum, cnt, mine, sp = 0u;
    for (;;) {
        sum = 0u; cnt = 0u; mine = 0u;
#pragma unroll
        for (unsigned j = 0; j < 16; ++j) { const unsigned c = xb_ld(&bar[XB_XCNT(j)]); sum += c; cnt += (c > 0u) ? 1u : 0u; mine = (j == x) ? c : mine; }
        if (sum == G) break;
        __builtin_amdgcn_s_sleep(1);
        if ((++sp & 255u) == 0u) { if (xb_ld(&bar[XB_TMO])) break; if (sp > XB_SPIN_CAP) { atomicAdd(&bar[XB_TMO], 1u); break; } }
    }
    nloc = mine > 0u ? mine : 1u; nx = cnt > 0u ? cnt : 1u;
}
__device__ __forceinline__ void xcd_barrier(const XcdBarrier& b) {
    asm volatile("s_waitcnt vmcnt(0)" ::: "memory");
    __syncthreads();
    if (threadIdx.x == 0) {
        unsigned* bar = b.bar;
        __builtin_amdgcn_s_waitcnt(0);
        unsigned nloc = b.st[0], nx = b.st[1];
        if (nloc == 0u) { xcd_barrier_complete(bar, b.x, nloc, nx); b.st[0] = nloc; b.st[1] = nx; }
        const unsigned old = xb_add(&bar[XB_XSUB(b.x)], 1u);
        const unsigned gen = old / nloc;
        if (old + 1u == (gen + 1u) * nloc) {
            __builtin_amdgcn_fence(__ATOMIC_RELEASE, "agent");
            asm volatile("s_waitcnt vmcnt(0)" ::: "memory");
            const unsigned og = xb_add(&bar[XB_TOP], 1u);
            const unsigned tg = og / nx;
            if (og + 1u == (tg + 1u) * nx) xb_add(&bar[XB_TOPGEN], 1u);
            else XB_SPIN(xb_ld(&bar[XB_TOPGEN]) == tg, bar);
            __builtin_amdgcn_fence(__ATOMIC_ACQUIRE, "agent");
            xb_add(&bar[XB_XGEN(b.x)], 1u);
            asm volatile("s_waitcnt vmcnt(0)" ::: "memory");
        } else {
            XB_SPIN(xb_ld(&bar[XB_XGEN(b.x)]) == gen, bar);
            __builtin_amdgcn_fence(__ATOMIC_ACQUIRE, "agent");
            asm volatile("s_waitcnt vmcnt(0)" ::: "memory");
        }
    }
    __syncthreads();
}

__device__ __forceinline__ void transpose_item(const float* __restrict__ W, int N, bf16_t* __restrict__ WT, int ldk, int row_off, LAS float* scr, int item, int lane) {
    const int nblk = N / 32, kb = item / nblk, nb = item % nblk, k0 = 64 * kb, n0 = 32 * nb;
#pragma unroll 8
    for (int i = 0; i < 32; ++i) { const int kk = 2 * i + (lane >> 5); scr[kk * 33 + (lane & 31)] = W[(size_t)(k0 + kk) * N + n0 + (lane & 31)]; }
    asm volatile("s_waitcnt lgkmcnt(0)" ::: "memory");
    const int c = lane & 7;
#pragma unroll
    for (int j = 0; j < 4; ++j) { const int n = (lane >> 3) + 8 * j; const LAS float* s = scr + (8 * c) * 33 + n;
        u32x4 o; o.x = cvt_pk_bf16(s[0 * 33], s[1 * 33]); o.y = cvt_pk_bf16(s[2 * 33], s[3 * 33]); o.z = cvt_pk_bf16(s[4 * 33], s[5 * 33]); o.w = cvt_pk_bf16(s[6 * 33], s[7 * 33]);
        *(u32x4*)(WT + (size_t)(row_off + n0 + n) * ldk + k0 + 8 * c) = o; }
    asm volatile("s_waitcnt lgkmcnt(0)" ::: "memory");
}
__device__ __forceinline__ void transpose_item_ln(const float* __restrict__ W, int N, bf16_t* __restrict__ WT, int ldk, const float* __restrict__ gk, const float* __restrict__ bk,
                                                  float* __restrict__ pcs, float* __restrict__ pbw, LAS float* scr, int item, int lane) {
    const int nblk = N / 32, kb = item / nblk, nb = item % nblk, k0 = 64 * kb, n0 = 32 * nb;
#pragma unroll 8
    for (int i = 0; i < 32; ++i) { const int kk = 2 * i + (lane >> 5); scr[kk * 33 + (lane & 31)] = W[(size_t)(k0 + kk) * N + n0 + (lane & 31)]; }
    asm volatile("s_waitcnt lgkmcnt(0)" ::: "memory");
    const int c = lane & 7;
    float gv[8], bv[8];
#pragma unroll
    for (int i = 0; i < 8; ++i) { gv[i] = gk[k0 + 8 * c + i]; bv[i] = bk[k0 + 8 * c + i]; }
#pragma unroll
    for (int j = 0; j < 4; ++j) { const int n = (lane >> 3) + 8 * j; const LAS float* s = scr + (8 * c) * 33 + n;
        float w[8]; float sb = 0.f;
#pragma unroll
        for (int i = 0; i < 8; ++i) { const float x = s[i * 33]; sb = fmaf(bv[i], x, sb); w[i] = x * gv[i]; }
        u32x4 o; o.x = cvt_pk_bf16(w[0], w[1]); o.y = cvt_pk_bf16(w[2], w[3]); o.z = cvt_pk_bf16(w[4], w[5]); o.w = cvt_pk_bf16(w[6], w[7]);
        *(u32x4*)(WT + (size_t)(n0 + n) * ldk + k0 + 8 * c) = o;
        float sc = ((__uint_as_float(o.x << 16) + __uint_as_float(o.x & 0xffff0000u)) + (__uint_as_float(o.y << 16) + __uint_as_float(o.y & 0xffff0000u)))
                 + ((__uint_as_float(o.z << 16) + __uint_as_float(o.z & 0xffff0000u)) + (__uint_as_float(o.w << 16) + __uint_as_float(o.w & 0xffff0000u)));
        sc += __shfl_xor(sc, 1); sc += __shfl_xor(sc, 2); sc += __shfl_xor(sc, 4);
        sb += __shfl_xor(sb, 1); sb += __shfl_xor(sb, 2); sb += __shfl_xor(sb, 4);
        if (c == 0) { pcs[(size_t)kb * N + n0 + n] = sc; pbw[(size_t)kb * N + n0 + n] = sb; } }
    asm volatile("s_waitcnt lgkmcnt(0)" ::: "memory");
}

struct Params {
    const float *x, *w_in, *conv_w, *a_log, *dt_bias, *dn_norm_w, *attn_sink, *rel_bias, *w_out, *ln1_g, *ln1_b, *peer_wq, *peer_keys, *peer_u, *peer_v, *ln2_g, *ln2_b;
    float* out;
    bf16_t *R, *WOUTT, *WQT;
    bf16_t *AQ, *AK, *AVT, *DQ, *DK, *DV, *DZ; float* BG;
    bf16_t *MIX, *HB, *QP;
    float *PART, *PCS, *PBW, *CS, *BW, *GATE, *US, *VS;
    bf16_t* PREB;
    unsigned char *U8, *V8;
    unsigned* BAR;
    unsigned* FLAG;
    bf16_t *OF, *OB;
    unsigned char *DNS, *DND;
    int* EIDX;
};

__device__ __forceinline__ void phase_prep(const Params& p, LAS unsigned char* lds) {
    int tid_ = threadIdx.x; asm volatile("" : "+v"(tid_) :: "memory");
    const int tid = tid_, wave = tid >> 6, lane = tid & 63, G = gridDim.x;
    {
        const size_t n8 = (size_t)T * D / 8, stride = (size_t)G * NTHREADS;
        for (size_t i = (size_t)blockIdx.x * NTHREADS + tid; i < n8; i += 4 * stride) {
            f32x4 a[4], b[4];
#pragma unroll
            for (int u = 0; u < 4; ++u) { const size_t q = i + u * stride < n8 ? i + u * stride : i; a[u] = __builtin_nontemporal_load((const f32x4*)(p.x + q * 8)); b[u] = __builtin_nontemporal_load((const f32x4*)(p.x + q * 8 + 4)); }
#pragma unroll
            for (int u = 0; u < 4; ++u) {
                u32x4 o; o.x = cvt_pk_bf16(a[u][0], a[u][1]); o.y = cvt_pk_bf16(a[u][2], a[u][3]); o.z = cvt_pk_bf16(b[u][0], b[u][1]); o.w = cvt_pk_bf16(b[u][2], b[u][3]);
                if (i + u * stride < n8) *(u32x4*)(p.R + (i + u * stride) * 8) = o;
            }
        }
    }
    {
        const size_t n16 = (size_t)(5888 - INW) * D * 2 / 16;
        u32x4* z = (u32x4*)(p.R + (size_t)(T + INW) * D);
        for (size_t i = (size_t)blockIdx.x * NTHREADS + tid; i < n16; i += (size_t)G * NTHREADS) z[i] = (u32x4){0u, 0u, 0u, 0u};
    }
    LAS float* scr = (LAS float*)(lds + wave * 8704);
    const int gw = blockIdx.x * 8 + wave, NGW = G * 8;
    constexpr int I_IN = (D / 64) * (INW / 32);
    for (int it = gw; it < I_IN; it += NGW) transpose_item(p.w_in, INW, p.R, D, T, scr, it, lane);
}
__device__ __forceinline__ void phase_prep_late(const Params& p, LAS unsigned char* lds, int bidx, int nblk) {
    int tid_ = threadIdx.x; asm volatile("" : "+v"(tid_) :: "memory");
    const int wave = tid_ >> 6, lane = tid_ & 63;
    LAS float* scr = (LAS float*)(lds + wave * 8704);
    constexpr int I_SQ = (D / 64) * (D / 32);
    for (int it = bidx * 8 + wave; it < 2 * I_SQ; it += nblk * 8) {
        if (it < I_SQ) transpose_item(p.w_out, D, p.WOUTT, D, 0, scr, it, lane);
        else transpose_item_ln(p.peer_wq, D, p.WQT, D, p.ln1_g, p.ln1_b, p.PCS, p.PBW, scr, it - I_SQ, lane);
    }
}

__device__ __forceinline__ void ln_body(int vb, int tid, char* sm, const float* __restrict__ X, const float* __restrict__ g, const float* __restrict__ bta, float* __restrict__ Y, bf16_t* __restrict__ Yb) {
    float* red = (float*)sm;
    const int t = vb;
    __syncthreads();
    const float4* xr = (const float4*)(X + (size_t)t * 2048);
    const float4 a = xr[tid], c = xr[tid + 256];
    float s = (a.x + a.y) + (a.z + a.w) + (c.x + c.y) + (c.z + c.w);
    s = wave_sum(s);
    if ((tid & 63) == 0) red[tid >> 6] = s;
    __syncthreads();
    const float mean = (red[0] + red[1] + red[2] + red[3]) * (1.0f / 2048.0f);
    __syncthreads();
    const float d0 = a.x - mean, d1 = a.y - mean, d2 = a.z - mean, d3 = a.w - mean, d4 = c.x - mean, d5 = c.y - mean, d6 = c.z - mean, d7 = c.w - mean;
    float q = d0 * d0 + d1 * d1 + d2 * d2 + d3 * d3 + d4 * d4 + d5 * d5 + d6 * d6 + d7 * d7;
    q = wave_sum(q);
    if ((tid & 63) == 0) red[tid >> 6] = q;
    __syncthreads();
    const float rstd = 1.0f / sqrtf((red[0] + red[1] + red[2] + red[3]) * (1.0f / 2048.0f) + LN_EPS);
    const float4 g0 = ((const float4*)g)[tid], g1 = ((const float4*)g)[tid + 256], b0 = ((const float4*)bta)[tid], b1 = ((const float4*)bta)[tid + 256];
    float4 o0, o1;
    o0.x = d0 * rstd * g0.x + b0.x; o0.y = d1 * rstd * g0.y + b0.y; o0.z = d2 * rstd * g0.z + b0.z; o0.w = d3 * rstd * g0.w + b0.w;
    o1.x = d4 * rstd * g1.x + b1.x; o1.y = d5 * rstd * g1.y + b1.y; o1.z = d6 * rstd * g1.z + b1.z; o1.w = d7 * rstd * g1.w + b1.w;
    float4* yr = (float4*)(Y + (size_t)t * 2048);
    yr[tid] = o0; yr[tid + 256] = o1;
    u32x2 w0, w1; w0.x = cvt_pk_bf16(o0.x, o0.y); w0.y = cvt_pk_bf16(o0.z, o0.w); w1.x = cvt_pk_bf16(o1.x, o1.y); w1.y = cvt_pk_bf16(o1.z, o1.w);
    u32x2* ybr = (u32x2*)(Yb + (size_t)t * 2048);
    ybr[tid] = w0; ybr[tid + 256] = w1;
}

__device__ __forceinline__ void wave_argmax(float& v, int& i) {
#pragma unroll
    for (int o = 1; o < 64; o <<= 1) {
        const float ov = __shfl_xor(v, o); const int oi = __shfl_xor(i, o);
        if (ov > v || (ov == v && oi < i)) { v = ov; i = oi; }
    }
}
template <class TQ>
__device__ __forceinline__ void select_body(int vb, int tid, char* sm, const TQ* __restrict__ Q, const float* __restrict__ keys, int* __restrict__ eidx, float* __restrict__ gate) {
    float (*qs)[256] = (float (*)[256])sm;
    float (*svs)[2][16] = (float (*)[2][16])(sm + 4096);
    int (*sis)[2][16] = (int (*)[2][16])(sm + 4096 + 512);
    const int wave = tid >> 6, lane = tid & 63;
    const int item = vb * 4 + wave, hd = item & 7, t = item >> 3;
    __syncthreads();
    const TQ* qrow = Q + (size_t)t * 2048 + hd * 256;
#pragma unroll
    for (int j = 0; j < 4; ++j) qs[wave][lane + 64 * j] = ldf(qrow + lane + 64 * j);
    __syncthreads();
    float sc[2][2];
#pragma unroll
    for (int pp = 0; pp < 2; ++pp)
#pragma unroll
        for (int kk = 0; kk < 2; ++kk) {
            const float4* kr = (const float4*)(keys + ((size_t)pp * 128 + lane + 64 * kk) * 128);
            float d = 0.f;
#pragma unroll 2
            for (int c = 0; c < 32; ++c) { const float4 kv = kr[c]; const float4 qv = *(const float4*)&qs[wave][pp * 128 + c * 4]; d += qv.x * kv.x + qv.y * kv.y + qv.z * kv.z + qv.w * kv.w; }
            sc[pp][kk] = d;
        }
#pragma unroll
    for (int pp = 0; pp < 2; ++pp) {
        for (int r = 0; r < 16; ++r) {
            float v; int i;
            if (sc[pp][0] >= sc[pp][1]) { v = sc[pp][0]; i = lane; } else { v = sc[pp][1]; i = lane + 64; }
            wave_argmax(v, i);
            if (lane == 0) { svs[wave][pp][r] = v; sis[wave][pp][r] = i; }
            if (i == lane) sc[pp][0] = -INFINITY;
            if (i == lane + 64) sc[pp][1] = -INFINITY;
        }
    }
    __syncthreads();
    float cs[4];
#pragma unroll
    for (int j = 0; j < 4; ++j) { const int c = lane + 64 * j; cs[j] = svs[wave][0][c >> 4] + svs[wave][1][c & 15]; }
    float tops = 0.f; int topc = 0;
    for (int r = 0; r < 16; ++r) {
        float v = cs[0]; int i = lane;
#pragma unroll
        for (int j = 1; j < 4; ++j) if (cs[j] > v) { v = cs[j]; i = lane + 64 * j; }
        wave_argmax(v, i);
        if (lane == r) { tops = v; topc = i; }
#pragma unroll
        for (int j = 0; j < 4; ++j) if (i == lane + 64 * j) cs[j] = -INFINITY;
    }
    float m = (lane < 16) ? tops : -INFINITY;
    m = wave_max(m);
    const float e = (lane < 16) ? expf(tops - m) : 0.f;
    const float den = wave_sum(e);
    if (lane < 16) {
        const int ex = sis[wave][0][topc >> 4] * 128 + sis[wave][1][topc & 15];
        eidx[(size_t)t * 128 + hd * 16 + lane] = ex;
        gate[(size_t)t * 128 + hd * 16 + lane] = e / den;
    }
}

__device__ __forceinline__ void gather_body(int vb, int tid, const float* __restrict__ H, const int* __restrict__ eidx, const float* __restrict__ gate, const float* __restrict__ U, const float* __restrict__ V,
                                            const float* __restrict__ g2, const float* __restrict__ b2, float* __restrict__ out) {
    const int wave = tid >> 6, lane = tid & 63;
    const int t = vb * 4 + wave;
    const float4* hr = (const float4*)(H + (size_t)t * 2048);
    float4 hv[8], acc[8];
#pragma unroll
    for (int j = 0; j < 8; ++j) { hv[j] = hr[lane + 64 * j]; acc[j] = make_float4(0.f, 0.f, 0.f, 0.f); }
    for (int pp = 0; pp < 128; ++pp) {
        const int e = eidx[(size_t)t * 128 + pp];
        const float gt = gate[(size_t)t * 128 + pp];
        const float4* ur = (const float4*)(U + (size_t)e * 2048);
        float d = 0.f;
#pragma unroll
        for (int j = 0; j < 8; ++j) { const float4 u = ur[lane + 64 * j]; d += u.x * hv[j].x + u.y * hv[j].y + u.z * hv[j].z + u.w * hv[j].w; }
        d = wave_sum(d);
        const float act = 0.5f * d * (1.0f + erff(d * 0.7071067811865476f));
        const float cf = act * gt;
        const float4* vr = (const float4*)(V + (size_t)e * 2048);
#pragma unroll
        for (int j = 0; j < 8; ++j) { const float4 vv = vr[lane + 64 * j]; acc[j].x += cf * vv.x; acc[j].y += cf * vv.y; acc[j].z += cf * vv.z; acc[j].w += cf * vv.w; }
    }
    float s = 0.f;
#pragma unroll
    for (int j = 0; j < 8; ++j) { acc[j].x += ALPHA * hv[j].x; acc[j].y += ALPHA * hv[j].y; acc[j].z += ALPHA * hv[j].z; acc[j].w += ALPHA * hv[j].w; s += (acc[j].x + acc[j].y) + (acc[j].z + acc[j].w); }
    const float mean = wave_sum(s) * (1.0f / 2048.0f);
    float q = 0.f;
#pragma unroll
    for (int j = 0; j < 8; ++j) { acc[j].x -= mean; acc[j].y -= mean; acc[j].z -= mean; acc[j].w -= mean; q += acc[j].x * acc[j].x + acc[j].y * acc[j].y + acc[j].z * acc[j].z + acc[j].w * acc[j].w; }
    const float rstd = 1.0f / sqrtf(wave_sum(q) * (1.0f / 2048.0f) + LN_EPS);
    float4* orow = (float4*)(out + (size_t)t * 2048);
#pragma unroll
    for (int j = 0; j < 8; ++j) {
        const float4 g = ((const float4*)g2)[lane + 64 * j], bb = ((const float4*)b2)[lane + 64 * j];
        float4 o; o.x = acc[j].x * rstd * g.x + bb.x; o.y = acc[j].y * rstd * g.y + bb.y; o.z = acc[j].z * rstd * g.z + bb.z; o.w = acc[j].w * rstd * g.w + bb.w;
        orow[lane + 64 * j] = o;
    }
}

constexpr int DNS_QN = 0, DNS_KNT = 16384, DNS_SIZE = 32768;
constexpr int DND_WN = 0, DND_UT = 16384, DND_AM = 32768, DND_EG = 40960, DND_EGL = 41216, DND_GL = 41472, DND_SIZE = 41984;

__device__ __forceinline__ f32x4 mfma16(bf16x8 a, bf16x8 b, f32x4 c) { return __builtin_amdgcn_mfma_f32_16x16x32_bf16(a, b, c, 0, 0, 0); }
template <int CTRL> __device__ __forceinline__ float dpp_mov(float v) { return __int_as_float(__builtin_amdgcn_update_dpp(0, __float_as_int(v), CTRL, 0xF, 0xF, true)); }
__device__ __forceinline__ float quad_sum(float v) { v += dpp_mov<0xB1>(v); v += dpp_mov<0x4E>(v); return v; }
__device__ __forceinline__ float row16_sum(float v) { v = quad_sum(v); v += dpp_mov<0x141>(v); v += dpp_mov<0x140>(v); return v; }

template <int MODE> __device__ __forceinline__ void gst64(void* ptr, u32x2 v) {
    if (MODE) __hip_atomic_store((unsigned long long*)ptr, ((unsigned long long)v.y << 32) | (unsigned long long)v.x, __ATOMIC_RELAXED, __HIP_MEMORY_SCOPE_AGENT);
    else *(u32x2*)ptr = v;
}
template <int MODE> __device__ __forceinline__ void gst128(void* ptr, u32x4 v) {
    if (MODE) { gst64<1>(ptr, (u32x2){v.x, v.y}); gst64<1>((unsigned char*)ptr + 8, (u32x2){v.z, v.w}); }
    else *(u32x4*)ptr = v;
}
template <int MODE> __device__ __forceinline__ void gst32(float* ptr, float v) {
    if (MODE) __hip_atomic_store(ptr, v, __ATOMIC_RELAXED, __HIP_MEMORY_SCOPE_AGENT);
    else *ptr = v;
}
constexpr int DN_LEVEL0 = 20;
template <int MODE>
__device__ __forceinline__ void phase_dnprep(const Params& p, LAS unsigned char* lds) {
    constexpr int L_QN = 0, L_KN = 17408;
    constexpr int L_KT = 34816, L_VT = L_KT + 18432;
    constexpr int L_T = L_VT + 18432;
    constexpr int L_CW = L_T + 4 * 9216;
    constexpr int L_SM = L_CW + 7680;
    int tid_ = threadIdx.x; asm volatile("" : "+v"(tid_) :: "memory");
    LAS float* convw = (LAS float*)(lds + L_CW);
    LAS float* betas = (LAS float*)(lds + L_SM);
    LAS float* Gs = betas + 128;
    int prev_it = -1;
#pragma unroll 1
    for (int ii = 0; ii < (MODE ? 4 : 5); ++ii) {
        const int nn = MODE == 0 ? (int)blockIdx.x + 256 * ii : 64 * DN_LEVEL0 + 192 * ii + ((int)blockIdx.x - 64);
        const int it = (nn & 31) * 64 + ((nn & 32) ? 63 - (nn >> 6) : (nn >> 6));
        asm volatile("" : "+v"(tid_) :: "memory");
        const int tid = tid_, wave = tid >> 6, lane = tid & 63, n16 = lane & 15, g = lane >> 4;
        const int c = it & 63, bh = it >> 6, h = bh & 7, b = bh >> 3;
        const size_t t0 = (size_t)b * S + c * 64;
        unsigned char* srec = p.DNS + (size_t)it * DNS_SIZE;
        unsigned char* drec0 = p.DND + (size_t)it * 2 * DND_SIZE;
        const int r32 = tid >> 4, cg = tid & 15;
        u32x4 raw0[3][5], raw1[3][5];
#define DN_LOAD_RAW(RAW, PASS, tensor) { \
            const bf16_t* base = ((tensor) == 0 ? p.DQ : ((tensor) == 1 ? p.DK : p.DV)) + (size_t)b * S * 1024 + h * 128 + 8 * cg; \
            _Pragma("unroll") for (int j = 0; j < 5; ++j) { const int sj = c * 64 + (PASS) * 32 + r32 + j - 2; const bool ok = (sj >= 0 && sj < S); \
                const u32x4 ld = *(const u32x4*)(base + (size_t)(ok ? sj : 0) * 1024); RAW[tensor][j] = ok ? ld : (u32x4){0u, 0u, 0u, 0u}; } }
        DN_LOAD_RAW(raw0, 0, 0) DN_LOAD_RAW(raw0, 0, 1) DN_LOAD_RAW(raw0, 0, 2)
        for (int i = tid; i < 1920; i += NTHREADS) { const int tensor = i / 640, rem = i % 640, j = rem >> 7, ch = rem & 127; convw[i] = p.conv_w[j * 3072 + tensor * 1024 + h * 128 + ch]; }
        if (tid < 128) {
            const int dir = tid >> 6, r = tid & 63;
            const float braw = p.BG[(t0 + r) * 32 + dir * 8 + h], araw = p.BG[(t0 + r) * 32 + 16 + dir * 8 + h];
            const float beta = sigmoid_f(braw);
            const float gg = -expf(p.a_log[dir * 8 + h]) * softplus_f(araw + p.dt_bias[dir * 8 + h]);
            float Gc = gg;
#pragma unroll
            for (int o = 1; o < 64; o <<= 1) { const float up = __shfl_up(Gc, o), dn = __shfl_down(Gc, o); if (dir == 0) { if (r >= o) Gc += up; } else { if (r + o < 64) Gc += dn; } }
            const float Glast = __shfl(Gc, dir ? 0 : 63);
            betas[dir * 64 + r] = beta; Gs[dir * 64 + r] = Gc * 1.4426950408889634f;
            float* eg = (float*)(drec0 + (size_t)dir * DND_SIZE + DND_EG);
            gst32<MODE>(eg + r, expf(Gc)); gst32<MODE>(eg + 64 + r, expf(Glast - Gc));
            if (r == 0) gst32<MODE>(eg + 128, expf(Glast));
        }
        if (MODE) asm volatile("s_waitcnt vmcnt(0)" ::: "memory");
        __syncthreads();
        if (MODE && threadIdx.x == 0 && prev_it >= 0) (void)xb_add(&p.FLAG[prev_it], 1u);
#pragma unroll
        for (int pass = 0; pass < 2; ++pass) {
            const int r = pass * 32 + r32;
            const int tro = (((r >> 3) ^ (cg & 7)) << 4) + (r & 7) * 2;
#pragma unroll
            for (int tensor = 0; tensor < 3; ++tensor) {
                asm volatile("" ::: "memory");
                if (pass == 0) DN_LOAD_RAW(raw1, 1, tensor)
                asm volatile("" ::: "memory");
                float a[8];
#pragma unroll
                for (int i = 0; i < 8; ++i) a[i] = 0.f;
#pragma unroll
                for (int j = 0; j < 5; ++j) {
                    const u32x4 rw = pass ? raw1[tensor][j] : raw0[tensor][j];
                    const f32x4 w0 = *(const LAS f32x4*)(convw + tensor * 640 + j * 128 + 8 * cg), w1 = *(const LAS f32x4*)(convw + tensor * 640 + j * 128 + 8 * cg + 4);
                    a[0] = fmaf(w0[0], __uint_as_float(rw.x << 16), a[0]); a[1] = fmaf(w0[1], __uint_as_float(rw.x & 0xffff0000u), a[1]);
                    a[2] = fmaf(w0[2], __uint_as_float(rw.y << 16), a[2]); a[3] = fmaf(w0[3], __uint_as_float(rw.y & 0xffff0000u), a[3]);
                    a[4] = fmaf(w1[0], __uint_as_float(rw.z << 16), a[4]); a[5] = fmaf(w1[1], __uint_as_float(rw.z & 0xffff0000u), a[5]);
                    a[6] = fmaf(w1[2], __uint_as_float(rw.w << 16), a[6]); a[7] = fmaf(w1[3], __uint_as_float(rw.w & 0xffff0000u), a[7]);
                }
                float y[8]; float ss = 0.f;
#pragma unroll
                for (int i = 0; i < 8; ++i) { y[i] = silu_f(a[i]); ss = fmaf(y[i], y[i], ss); }
                if (tensor < 2) {
                    ss = row16_sum(ss);
                    const float rn = __builtin_amdgcn_rsqf(ss + RMS_EPS) * (tensor == 0 ? 0.08838834764831845f : 1.0f);
#pragma unroll
                    for (int i = 0; i < 8; ++i) y[i] *= rn;
                    u32x4 pv; pv.x = cvt_pk_bf16(y[0], y[1]); pv.y = cvt_pk_bf16(y[2], y[3]); pv.z = cvt_pk_bf16(y[4], y[5]); pv.w = cvt_pk_bf16(y[6], y[7]);
                    *(LAS u32x4*)(lds + (tensor == 0 ? L_QN : L_KN) + r * 272 + cg * 16) = pv;
                    if (tensor == 0) gst128<MODE>(srec + DNS_QN + r * 256 + cg * 16, pv);
                }
                if (tensor >= 1) {
#pragma unroll
                    for (int i = 0; i < 8; ++i) *(LAS bf16_t*)(lds + (tensor == 1 ? L_KT : L_VT) + (8 * cg + i) * 144 + tro) = f2bf(y[i]);
                }
            }
        }
#undef DN_LOAD_RAW
        __syncthreads();
        {
#pragma unroll
            for (int i = 0; i < 2; ++i) { const int q = tid + NTHREADS * i, row = q >> 3, c8 = q & 7;
                gst128<MODE>(srec + DNS_KNT + row * 128 + c8 * 16, *(const LAS u32x4*)(lds + L_KT + row * 144 + ((c8 ^ ((row >> 3) & 7)) << 4))); }
        }
        f32x4 kk2[2], qk2[2];
#pragma unroll
        for (int jb = 0; jb < 2; ++jb) {
            const int job = wave * 2 + jb, ta = job >> 2, tb = job & 3;
            f32x4 ak = (f32x4){0.f, 0.f, 0.f, 0.f}, aq = (f32x4){0.f, 0.f, 0.f, 0.f};
#pragma unroll
            for (int ks = 0; ks < 4; ++ks) {
                const bf16x8 ka = *(const LAS bf16x8*)(lds + L_KN + (16 * ta + n16) * 272 + ks * 64 + g * 16);
                const bf16x8 kb = *(const LAS bf16x8*)(lds + L_KN + (16 * tb + n16) * 272 + ks * 64 + g * 16);
                const bf16x8 qb = *(const LAS bf16x8*)(lds + L_QN + (16 * tb + n16) * 272 + ks * 64 + g * 16);
                ak = mfma16(ka, kb, ak);
                aq = mfma16(ka, qb, aq);
            }
            kk2[jb] = ak; qk2[jb] = aq;
        }
        __syncthreads();
#pragma unroll
        for (int jb = 0; jb < 2; ++jb) {
            const int job = wave * 2 + jb, ta = job >> 2, tb = job & 3;
            {
                const int j = 16 * tb + n16;
                const float G0j = Gs[j], G1j = Gs[64 + j];
#pragma unroll
                for (int rr = 0; rr < 4; ++rr) {
                    const int i = 16 * ta + 4 * g + rr;
                    const float kkv = kk2[jb][rr];
                    const float l0 = (j < i) ? betas[i] * kkv * __builtin_amdgcn_exp2f(Gs[i] - G0j) : 0.f;
                    const float l1 = (j > i) ? betas[64 + i] * kkv * __builtin_amdgcn_exp2f(Gs[64 + i] - G1j) : 0.f;
                    *(LAS float*)(lds + L_QN + (i * 64 + (j & 3) * 16 + (j >> 2)) * 4) = l0;
                    const int ir = 63 - i, jr = 63 - j;
                    *(LAS float*)(lds + L_KN + (ir * 64 + (jr & 3) * 16 + (jr >> 2)) * 4) = l1;
                }
            }
            {
                const int i = 16 * tb + n16;
                const float G0i = Gs[i], G1i = Gs[64 + i];
                float a0[4], a1[4];
#pragma unroll
                for (int rr = 0; rr < 4; ++rr) {
                    const int j = 16 * ta + 4 * g + rr;
                    const float qkv = qk2[jb][rr];
                    a0[rr] = (j <= i) ? qkv * __builtin_amdgcn_exp2f(G0i - Gs[j]) : 0.f;
                    a1[rr] = (j >= i) ? qkv * __builtin_amdgcn_exp2f(G1i - Gs[64 + j]) : 0.f;
                }
                u32x2 w0, w1; w0.x = cvt_pk_bf16(a0[0], a0[1]); w0.y = cvt_pk_bf16(a0[2], a0[3]); w1.x = cvt_pk_bf16(a1[0], a1[1]); w1.y = cvt_pk_bf16(a1[2], a1[3]);
                gst64<MODE>(drec0 + DND_AM + (i * 64 + 16 * ta + 4 * g) * 2, w0);
                gst64<MODE>(drec0 + DND_SIZE + DND_AM + (i * 64 + 16 * ta + 4 * g) * 2, w1);
            }
        }
        __syncthreads();
        {
            const int dir = wave >> 2, cb = __builtin_amdgcn_readfirstlane(dir ? 3 - (wave & 3) : (wave & 3)), nblk = 4 - cb, cl = lane >> 2, q = lane & 3;
            const LAS float* Lq = (const LAS float*)(lds + (dir ? L_KN : L_QN)) + q * 16 + (16 * cb) * 64 + 4 * cb;
            float Tq[16];
#pragma unroll
            for (int m = 0; m < 16; ++m) Tq[m] = 0.f;
            f32x4 lv[2][4];
            lv[0][0] = *(const LAS f32x4*)(Lq);
#define S3_STEPS(LO) _Pragma("unroll") for (int i = (LO); i < (LO) + 16; ++i) { \
                const int mi = i >> 2, qi = i & 3; \
                if (i < 63) { _Pragma("unroll") for (int mm = 0; mm <= ((i + 1) >> 4); ++mm) lv[(i + 1) & 1][mm] = *(const LAS f32x4*)(Lq + (i + 1) * 64 + 4 * mm); } \
                float acc0 = 0.f, acc1 = 0.f; \
                _Pragma("unroll") for (int mm = 0; mm <= (mi >> 2); ++mm) { \
                    const f32x4 l4 = lv[i & 1][mm]; \
                    acc0 = fmaf(l4[0], Tq[4 * mm], acc0); acc1 = fmaf(l4[1], Tq[4 * mm + 1], acc1); \
                    acc0 = fmaf(l4[2], Tq[4 * mm + 2], acc0); acc1 = fmaf(l4[3], Tq[4 * mm + 3], acc1); } \
                const float tot = quad_sum(acc0 + acc1); \
                const float val = ((cl == i) ? 1.0f : 0.0f) - tot; \
                Tq[mi] = (q == qi) ? val : Tq[mi]; }
            S3_STEPS(0)
            if (nblk > 1) { S3_STEPS(16)
                if (nblk > 2) { S3_STEPS(32)
                    if (nblk > 3) { S3_STEPS(48) } } }
#undef S3_STEPS
            const int cidx = 16 * cb + cl;
            const int col = dir ? (63 - cidx) : cidx;
            const float bc = betas[dir * 64 + col], bgc = bc * __builtin_amdgcn_exp2f(Gs[dir * 64 + col]);
#pragma unroll
            for (int m = 0; m < 16; ++m) {
                if (m < 4 * nblk) {
                    const int i = 16 * cb + 4 * m + q;
                    const int row = dir ? (63 - i) : i;
                    *(LAS bf16_t*)(lds + L_T + dir * 9216 + row * 144 + col * 2) = f2bf(Tq[m] * bc);
                    *(LAS bf16_t*)(lds + L_T + (2 + dir) * 9216 + row * 144 + col * 2) = f2bf(Tq[m] * bgc);
                } else {
                    const int i = 4 * (m - 4 * nblk) + q;
                    const int row = dir ? (63 - i) : i;
                    *(LAS bf16_t*)(lds + L_T + dir * 9216 + row * 144 + col * 2) = (bf16_t)0;
                    *(LAS bf16_t*)(lds + L_T + (2 + dir) * 9216 + row * 144 + col * 2) = (bf16_t)0;
                }
            }
        }
        __syncthreads();
#pragma unroll 4
        for (int jj = 0; jj < 16; ++jj) {
            const int job = wave * 16 + jj, dir = job >> 6, kind = (job >> 5) & 1, tl = job & 31;
            const LAS unsigned char* Tb = lds + L_T + (2 * kind + dir) * 9216;
            unsigned char* drec = drec0 + (size_t)dir * DND_SIZE;
            f32x4 acc = (f32x4){0.f, 0.f, 0.f, 0.f};
            if (kind == 0) {
                const int itl = tl >> 3, ct = tl & 7, ch = 16 * ct + n16;
                const LAS unsigned char* Vb = lds + L_VT + ch * 144;
#pragma unroll
                for (int ks = 0; ks < 2; ++ks) {
                    const bf16x8 a = *(const LAS bf16x8*)(Tb + (16 * itl + n16) * 144 + ks * 64 + g * 16);
                    const bf16x8 bb = *(const LAS bf16x8*)(Vb + (((4 * ks + g) ^ ((ch >> 3) & 7)) << 4));
                    acc = mfma16(a, bb, acc);
                }
                u32x2 w; w.x = cvt_pk_bf16(acc[0], acc[1]); w.y = cvt_pk_bf16(acc[2], acc[3]);
                gst64<MODE>(drec + DND_UT + (ch * 64 + 16 * itl + 4 * g) * 2, w);
            } else {
                const int dt = tl >> 2, itl = tl & 3, dk = 16 * dt + n16;
                const LAS unsigned char* Kb = lds + L_KT + dk * 144;
#pragma unroll
                for (int ks = 0; ks < 2; ++ks) {
                    const bf16x8 a = *(const LAS bf16x8*)(Kb + (((4 * ks + g) ^ ((dk >> 3) & 7)) << 4));
                    const bf16x8 bb = *(const LAS bf16x8*)(Tb + (16 * itl + n16) * 144 + ks * 64 + g * 16);
                    acc = mfma16(a, bb, acc);
                }
                u32x2 w; w.x = cvt_pk_bf16(-acc[0], -acc[1]); w.y = cvt_pk_bf16(-acc[2], -acc[3]);
                gst64<MODE>(drec + DND_WN + ((16 * itl + n16) * 128 + 16 * dt + 4 * g) * 2, w);
            }
        }
        __syncthreads();
        prev_it = it;
    }
    if (MODE) {
        asm volatile("s_waitcnt vmcnt(0)" ::: "memory");
        __syncthreads();
        if (threadIdx.x == 0 && prev_it >= 0) (void)xb_add(&p.FLAG[prev_it], 1u);
    }
}

__device__ __forceinline__ void phase_dnscan(const Params& p, LAS unsigned char* lds) {
    constexpr int B_WN = 0, B_QN = 16384, B_AM = 32768, B_KNT = 40960, B_EG = 57344, B_SIZE = 57344 + 1024;
    int tid_ = threadIdx.x; asm volatile("" : "+v"(tid_) :: "memory");
    const int tid = tid_, wave = tid >> 6, lane = tid & 63, n16 = lane & 15, g = lane >> 4;
    const int chain = blockIdx.x, dir = chain & 1, h = (chain >> 1) & 7, b = chain >> 4, bh = b * 8 + h;
    const int dv0 = wave * 16;
    bf16_t* O = dir ? p.OB : p.OF;
    int ldst1[7], ldst2[7];
#pragma unroll
    for (int i = 0; i < 7; ++i) {
        const int q = tid + NTHREADS * i;
        if (i < 4) {
            const int qq = q & 1023, row = qq >> 4, k8 = qq & 15, kb = k8 >> 2, c4 = k8 & 3;
            const int off1 = kb * 64 + (c4 & 1) * 32 + (c4 >> 1) * 8, off2 = off1 + 16;
            const int base = (i < 2 ? B_WN : B_QN) + row * 256, sw = (row & 15) << 4;
            ldst1[i] = base + (off1 ^ sw); ldst2[i] = base + (off2 ^ sw);
        } else {
            const int qq = (i == 4) ? (q - 2048) : (q - 2560), row = qq >> 3, c8 = qq & 7, kb = c8 >> 2, c4 = c8 & 3;
            const int off1 = kb * 64 + (c4 & 1) * 32 + (c4 >> 1) * 8, off2 = off1 + 16;
            const int base = (i == 4 ? B_AM : B_KNT) + row * 128, sw = ((row >> 1) & 7) << 4;
            ldst1[i] = base + (off1 ^ sw); ldst2[i] = base + (off2 ^ sw);
        }
    }
    u32x4 st[7]; u32x4 stg = (u32x4){0u, 0u, 0u, 0u}; u32x2 ut[4];
    auto issue_loads = [&](int cidx) {
        const int rec = bh * 64 + cidx;
        const unsigned char* srec = p.DNS + (size_t)rec * DNS_SIZE;
        const unsigned char* drec = p.DND + ((size_t)rec * 2 + dir) * DND_SIZE;
        st[0] = *(const u32x4*)(drec + DND_WN + tid * 16); st[1] = *(const u32x4*)(drec + DND_WN + (tid + 512) * 16);
        st[2] = *(const u32x4*)(srec + DNS_QN + tid * 16); st[3] = *(const u32x4*)(srec + DNS_QN + (tid + 512) * 16);
        st[4] = *(const u32x4*)(drec + DND_AM + tid * 16);
        st[5] = *(const u32x4*)(srec + DNS_KNT + tid * 16); st[6] = *(const u32x4*)(srec + DNS_KNT + (tid + 512) * 16);
        if (tid < 33) stg = *(const u32x4*)(drec + DND_EG + tid * 16);
#pragma unroll
        for (int m = 0; m < 4; ++m) ut[m] = *(const u32x2*)(drec + DND_UT + ((dv0 + n16) * 64 + 16 * m + 4 * g) * 2);
    };
    auto write_stage = [&](int buf) {
        LAS unsigned char* bb = lds + buf * B_SIZE;
#pragma unroll
        for (int i = 0; i < 7; ++i) { *(LAS u32x2*)(bb + ldst1[i]) = (u32x2){st[i].x, st[i].y}; *(LAS u32x2*)(bb + ldst2[i]) = (u32x2){st[i].z, st[i].w}; }
        if (tid < 33) *(LAS u32x4*)(bb + B_EG + tid * 16) = stg;
    };
    f32x4 Sst[8];
#pragma unroll
    for (int mm = 0; mm < 8; ++mm) Sst[mm] = (f32x4){0.f, 0.f, 0.f, 0.f};
    issue_loads(dir ? 63 : 0);
    write_stage(0);
    u32x2 utc[4];
#pragma unroll
    for (int m = 0; m < 4; ++m) utc[m] = ut[m];
    __syncthreads();
    unsigned fl = 1u;
#pragma unroll 1
    for (int k = 0; k < 64; ++k) {
        const int cidx = dir ? (63 - k) : k;
        if (k + 1 < 64) {
            const int cn = dir ? (62 - k) : (k + 1);
            if (fl == 0u) XB_SPIN(xb_ld(&p.FLAG[bh * 64 + cn]) == 0u, p.BAR);
            issue_loads(cn);
        }
        if (k + 2 < 64) { const int c2 = dir ? (61 - k) : (k + 2); fl = ((c2 < 32 ? c2 : 63 - c2) >= DN_LEVEL0) ? xb_ld(&p.FLAG[bh * 64 + c2]) : 1u; }
        const LAS unsigned char* bb = lds + (k & 1) * B_SIZE;
        bf16x8 BS[4];
#pragma unroll
        for (int ks = 0; ks < 4; ++ks) {
            u32x4 w; w.x = cvt_pk_bf16(Sst[2 * ks][0], Sst[2 * ks][1]); w.y = cvt_pk_bf16(Sst[2 * ks][2], Sst[2 * ks][3]);
            w.z = cvt_pk_bf16(Sst[2 * ks + 1][0], Sst[2 * ks + 1][1]); w.w = cvt_pk_bf16(Sst[2 * ks + 1][2], Sst[2 * ks + 1][3]);
            BS[ks] = __builtin_bit_cast(bf16x8, w);
        }
        f32x4 vn[4], oq[4];
        bf16x8 fw[2][4], fq[2][4];
#define SC_LD_WQ(slot, m) { const int rowo_ = (16 * (m) + n16) * 256, sw_ = n16 << 4; \
            _Pragma("unroll") for (int ks = 0; ks < 4; ++ks) { fw[slot][ks] = *(const LAS bf16x8*)(bb + B_WN + rowo_ + ((ks * 64 + g * 16) ^ sw_)); fq[slot][ks] = *(const LAS bf16x8*)(bb + B_QN + rowo_ + ((ks * 64 + g * 16) ^ sw_)); } }
        SC_LD_WQ(0, 0)
#pragma unroll
        for (int m = 0; m < 4; ++m) {
            if (m < 3) SC_LD_WQ((m + 1) & 1, m + 1)
            vn[m] = (f32x4){__uint_as_float(utc[m].x << 16), __uint_as_float(utc[m].x & 0xffff0000u), __uint_as_float(utc[m].y << 16), __uint_as_float(utc[m].y & 0xffff0000u)};
            oq[m] = (f32x4){0.f, 0.f, 0.f, 0.f};
#pragma unroll
            for (int ks = 0; ks < 4; ++ks) { vn[m] = mfma16(fw[m & 1][ks], BS[ks], vn[m]); oq[m] = mfma16(BS[ks], fq[m & 1][ks], oq[m]); }
            oq[m] = oq[m] * *(const LAS float*)(bb + B_EG + (16 * m + n16) * 4);
        }
#undef SC_LD_WQ
        bf16x8 fa[4][2];
#pragma unroll
        for (int m = 0; m < 4; ++m) { const int rowo = (16 * m + n16) * 128, sw = ((n16 >> 1) & 7) << 4;
#pragma unroll
            for (int ks = 0; ks < 2; ++ks) fa[m][ks] = *(const LAS bf16x8*)(bb + B_AM + rowo + ((ks * 64 + g * 16) ^ sw)); }
        bf16x8 BV[2], BVs[2];
#pragma unroll
        for (int ks = 0; ks < 2; ++ks) {
            const f32x4 e0 = *(const LAS f32x4*)(bb + B_EG + 256 + (32 * ks + 4 * g) * 4), e1 = *(const LAS f32x4*)(bb + B_EG + 256 + (32 * ks + 16 + 4 * g) * 4);
            const f32x4 a0 = vn[2 * ks], a1 = vn[2 * ks + 1], s0 = a0 * e0, s1 = a1 * e1;
            u32x4 w; w.x = cvt_pk_bf16(a0[0], a0[1]); w.y = cvt_pk_bf16(a0[2], a0[3]); w.z = cvt_pk_bf16(a1[0], a1[1]); w.w = cvt_pk_bf16(a1[2], a1[3]);
            BV[ks] = __builtin_bit_cast(bf16x8, w);
            u32x4 ws; ws.x = cvt_pk_bf16(s0[0], s0[1]); ws.y = cvt_pk_bf16(s0[2], s0[3]); ws.z = cvt_pk_bf16(s1[0], s1[1]); ws.w = cvt_pk_bf16(s1[2], s1[3]);
            BVs[ks] = __builtin_bit_cast(bf16x8, ws);
        }
        bf16x8 fk[2][4][2];
#define SC_LD_K(slot, half) { _Pragma("unroll") for (int q4 = 0; q4 < 4; ++q4) { const int rowo_ = (16 * (4 * (half) + q4) + n16) * 128, sw_ = ((n16 >> 1) & 7) << 4; \
            _Pragma("unroll") for (int ks = 0; ks < 2; ++ks) fk[slot][q4][ks] = *(const LAS bf16x8*)(bb + B_KNT + rowo_ + ((ks * 64 + g * 16) ^ sw_)); } }
        SC_LD_K(0, 0)
#pragma unroll
        for (int m = 0; m < 4; ++m) {
#pragma unroll
            for (int ks = 0; ks < 2; ++ks) oq[m] = mfma16(BV[ks], fa[m][ks], oq[m]);
            u32x2 w; w.x = cvt_pk_bf16(oq[m][0], oq[m][1]); w.y = cvt_pk_bf16(oq[m][2], oq[m][3]);
            *(u32x2*)(O + ((size_t)b * S + cidx * 64 + 16 * m + n16) * 1024 + h * 128 + dv0 + 4 * g) = w;
        }
        const float gl = *(const LAS float*)(bb + B_EG + 512);
        SC_LD_K(1, 1)
#pragma unroll
        for (int mm = 0; mm < 8; ++mm) {
            Sst[mm] = Sst[mm] * gl;
#pragma unroll
            for (int ks = 0; ks < 2; ++ks) Sst[mm] = mfma16(fk[mm >> 2][mm & 3][ks], BVs[ks], Sst[mm]);
        }
#undef SC_LD_K
        if (k + 1 < 64) {
            write_stage((k + 1) & 1);
#pragma unroll
            for (int m = 0; m < 4; ++m) utc[m] = ut[m];
        }
        __syncthreads();
    }
}

__device__ __forceinline__ void phase_dncombine(const Params& p) {
    int tid_ = threadIdx.x; asm volatile("" : "+v"(tid_) :: "memory");
    const int tid = tid_;
    {
        const int n = blockIdx.x * NTHREADS + tid;
        if (n < D) { float a = 0.f, bsum = 0.f;
#pragma unroll 8
            for (int kb = 0; kb < 32; ++kb) { a += p.PCS[(size_t)kb * D + n]; bsum += p.PBW[(size_t)kb * D + n]; }
            p.CS[n] = a; p.BW[n] = bsum; }
    }
    const int nitem = T * 8;
    for (int base = (blockIdx.x * NTHREADS + tid) >> 4; base < nitem; base += (gridDim.x * NTHREADS) >> 4) {
        const int l16 = tid & 15, h = base & 7, t = base >> 3;
        const size_t idx = (size_t)t * 1024 + h * 128 + 8 * l16;
        const u32x4 a = *(const u32x4*)(p.OF + idx), bq = *(const u32x4*)(p.OB + idx), z = *(const u32x4*)(p.DZ + idx);
        float o[8];
        o[0] = __uint_as_float(a.x << 16) + __uint_as_float(bq.x << 16); o[1] = __uint_as_float(a.x & 0xffff0000u) + __uint_as_float(bq.x & 0xffff0000u);
        o[2] = __uint_as_float(a.y << 16) + __uint_as_float(bq.y << 16); o[3] = __uint_as_float(a.y & 0xffff0000u) + __uint_as_float(bq.y & 0xffff0000u);
        o[4] = __uint_as_float(a.z << 16) + __uint_as_float(bq.z << 16); o[5] = __uint_as_float(a.z & 0xffff0000u) + __uint_as_float(bq.z & 0xffff0000u);
        o[6] = __uint_as_float(a.w << 16) + __uint_as_float(bq.w << 16); o[7] = __uint_as_float(a.w & 0xffff0000u) + __uint_as_float(bq.w & 0xffff0000u);
        float zz[8];
        zz[0] = __uint_as_float(z.x << 16); zz[1] = __uint_as_float(z.x & 0xffff0000u); zz[2] = __uint_as_float(z.y << 16); zz[3] = __uint_as_float(z.y & 0xffff0000u);
        zz[4] = __uint_as_float(z.z << 16); zz[5] = __uint_as_float(z.z & 0xffff0000u); zz[6] = __uint_as_float(z.w << 16); zz[7] = __uint_as_float(z.w & 0xffff0000u);
        float ss = 0.f;
#pragma unroll
        for (int i = 0; i < 8; ++i) ss = fmaf(o[i], o[i], ss);
        ss += __shfl_xor(ss, 1); ss += __shfl_xor(ss, 2); ss += __shfl_xor(ss, 4); ss += __shfl_xor(ss, 8);
        const float rn = __builtin_amdgcn_rsqf(ss * (1.0f / 128.0f) + RMS_EPS);
        const f32x4 nw0 = *(const f32x4*)(p.dn_norm_w + 8 * l16), nw1 = *(const f32x4*)(p.dn_norm_w + 8 * l16 + 4);
        float r[8];
#pragma unroll
        for (int i = 0; i < 8; ++i) r[i] = o[i] * rn * (i < 4 ? nw0[i] : nw1[i - 4]) * silu_f(zz[i]);
        u32x4 w; w.x = cvt_pk_bf16(r[0], r[1]); w.y = cvt_pk_bf16(r[2], r[3]); w.z = cvt_pk_bf16(r[4], r[5]); w.w = cvt_pk_bf16(r[6], r[7]);
        *(u32x4*)(p.MIX + (size_t)t * 2048 + 1024 + h * 128 + 8 * l16) = w;
    }
}

typedef float f32x16 __attribute__((ext_vector_type(16)));
__device__ __forceinline__ f32x16 mfma32(bf16x8 a, bf16x8 b, f32x16 c) { return __builtin_amdgcn_mfma_f32_32x32x16_bf16(a, b, c, 0, 0, 0); }
__device__ __forceinline__ void phase_attn(const Params& p, LAS unsigned char* lds, int bidx, int nblk) {
    constexpr float LOG2E = 1.4426950408889634f, C1 = 0.08838834764831845f * 1.4426950408889634f;
    constexpr int L_BT = 0;
    constexpr int L_K = 8448;
    constexpr int L_V = L_K + 16384;
    int tid_ = threadIdx.x; asm volatile("" : "+v"(tid_) :: "memory");
    const int tid = tid_, wave = tid >> 6, lane = tid & 63, n = lane & 31, h2 = lane >> 5;
    LAS float* btab = (LAS float*)(lds + L_BT);
    for (int i = tid; i < 8 * 257; i += NTHREADS) { const int hq = i / 257, r = i % 257; btab[hq * 260 + r] = p.rel_bias[t5_bucket(r - 128) * 8 + hq] * LOG2E; }
    __syncthreads();
#pragma unroll 1
    for (int it = bidx; it < 512; it += nblk) {
        const int span = it & 63, kvh = (it >> 6) & 1, b = it >> 7;
        const int gq = wave & 3, hq = kvh * 4 + gq, q0 = span * 64 + (wave >> 2) * 32;
        const int kbase = span * 64 - 128;
        const int skey = tid >> 4, sc16 = tid & 15, sd = tid >> 2, sc4 = tid & 3;
        const bf16_t* kg = p.AK + ((size_t)b * S + skey) * 256 + kvh * 128 + sc16 * 8;
        const bf16_t* vg = p.AVT + (size_t)(kvh * 128 + sd) * T + (size_t)b * S + sc4 * 8;
        const int kdst = L_K + skey * 256 + ((sc16 ^ (skey & 15)) << 4), vdst = L_V + sd * 72 + sc4 * 16;
        u32x4 kst, vst;
        auto tile_ok = [&](int j) { const int k0 = kbase + 32 * j; return k0 >= 0 && k0 < S; };
        auto issue = [&](int j) { const int k0 = kbase + 32 * j; if (k0 >= 0 && k0 < S) { kst = *(const u32x4*)(kg + (size_t)k0 * 256); vst = *(const u32x4*)(vg + k0); } };
        auto stage = [&](int buf) { *(LAS u32x4*)(lds + buf * 8192 + kdst) = kst;
                                    *(LAS u32x2*)(lds + buf * 9216 + vdst) = (u32x2){vst.x, vst.y}; *(LAS u32x2*)(lds + buf * 9216 + vdst + 8) = (u32x2){vst.z, vst.w}; };
        bf16x8 qf[8];
        {
            const bf16_t* qrow = p.AQ + ((size_t)b * S + q0 + n) * 1024 + hq * 128 + 8 * h2;
#pragma unroll
            for (int ks = 0; ks < 8; ++ks) qf[ks] = *(const bf16x8*)(qrow + 16 * ks);
        }
        f32x16 o[4];
#pragma unroll
        for (int mt = 0; mt < 4; ++mt)
#pragma unroll
            for (int r = 0; r < 16; ++r) o[mt][r] = 0.f;
        float m = p.attn_sink[hq] * LOG2E, l = h2 ? 0.f : 1.f;
        const LAS float* bt = btab + hq * 260 + 128;
        issue(0);
        if (tile_ok(0)) stage(0);
        __syncthreads();
#pragma unroll 1
        for (int j = 0; j < 10; ++j) {
            if (j + 1 < 10) issue(j + 1);
            const int k0 = kbase + 32 * j, kt = (k0 - q0) / 32;
            if (k0 >= 0 && k0 < S && kt >= -4 && kt <= 4) {
                const LAS unsigned char* kb = lds + (j & 1) * 8192 + L_K;
                const LAS unsigned char* vb = lds + (j & 1) * 9216 + L_V;
                f32x16 s;
#pragma unroll
                for (int r = 0; r < 16; ++r) s[r] = 0.f;
#pragma unroll
                for (int ks = 0; ks < 8; ++ks) {
                    const bf16x8 kf = *(const LAS bf16x8*)(kb + n * 256 + (((2 * ks + h2) ^ (n & 15)) << 4));
                    s = mfma32(kf, qf[ks], s);
                }
                u32x2 vf[2][4][2];
#pragma unroll
                for (int ss = 0; ss < 2; ++ss)
#pragma unroll
                    for (int mt = 0; mt < 4; ++mt) {
                        const LAS unsigned char* vr = vb + (32 * mt + n) * 72 + (16 * ss + 4 * h2) * 2;
                        vf[ss][mt][0] = *(const LAS u32x2*)vr; vf[ss][mt][1] = *(const LAS u32x2*)(vr + 16);
                    }
                float tmax = -INFINITY;
#pragma unroll
                for (int r = 0; r < 16; ++r) {
                    const int kr = (r & 3) + 8 * (r >> 2) + 4 * h2, rel = 32 * kt + kr - n;
                    const int ri = rel < -128 ? -128 : (rel > 128 ? 128 : rel);
                    float v = fmaf(s[r], C1, bt[ri]);
                    v = (rel >= -128 && rel <= 128) ? v : -INFINITY;
                    s[r] = v; tmax = fmaxf(tmax, v);
                }
                tmax = fmaxf(tmax, __shfl_xor(tmax, 32));
                const float mn = fmaxf(m, tmax), alpha = __builtin_amdgcn_exp2f(m - mn);
                m = mn; l *= alpha;
#pragma unroll
                for (int mt = 0; mt < 4; ++mt) o[mt] = o[mt] * alpha;
#pragma unroll
                for (int r = 0; r < 16; ++r) { const float pr = __builtin_amdgcn_exp2f(s[r] - mn); l += pr; s[r] = pr; }
#pragma unroll
                for (int ss = 0; ss < 2; ++ss) {
                    u32x4 pw; pw.x = cvt_pk_bf16(s[8 * ss], s[8 * ss + 1]); pw.y = cvt_pk_bf16(s[8 * ss + 2], s[8 * ss + 3]); pw.z = cvt_pk_bf16(s[8 * ss + 4], s[8 * ss + 5]); pw.w = cvt_pk_bf16(s[8 * ss + 6], s[8 * ss + 7]);
                    const bf16x8 pf = __builtin_bit_cast(bf16x8, pw);
#pragma unroll
                    for (int mt = 0; mt < 4; ++mt) {
                        const u32x4 vw = (u32x4){vf[ss][mt][0].x, vf[ss][mt][0].y, vf[ss][mt][1].x, vf[ss][mt][1].y};
                        o[mt] = mfma32(__builtin_bit_cast(bf16x8, vw), pf, o[mt]);
                    }
                }
            }
            if (j + 1 < 10 && tile_ok(j + 1)) stage((j + 1) & 1);
            __syncthreads();
        }
        const float inv = 1.0f / (l + __shfl_xor(l, 32));
        bf16_t* orow = p.MIX + ((size_t)b * S + q0 + n) * 2048 + hq * 128 + 4 * h2;
#pragma unroll
        for (int mt = 0; mt < 4; ++mt)
#pragma unroll
            for (int r4 = 0; r4 < 4; ++r4) {
                u32x2 w; w.x = cvt_pk_bf16(o[mt][4 * r4] * inv, o[mt][4 * r4 + 1] * inv); w.y = cvt_pk_bf16(o[mt][4 * r4 + 2] * inv, o[mt][4 * r4 + 3] * inv);
                *(u32x2*)(orow + 32 * mt + 8 * r4) = w;
            }
    }
    __syncthreads();
}

template <int N> __device__ __forceinline__ void sort_desc(float (&v)[N]) {
#pragma unroll
    for (int k = 2; k <= N; k <<= 1)
#pragma unroll
        for (int j = k >> 1; j > 0; j >>= 1)
#pragma unroll
            for (int i = 0; i < N; ++i) {
                const int l = i ^ j;
                if (l > i) {
                    const float hi = fmaxf(v[i], v[l]), lo = fminf(v[i], v[l]);
                    if ((i & k) == 0) { v[i] = hi; v[l] = lo; } else { v[i] = lo; v[l] = hi; }
                }
            }
}
template <int XORMASK> __device__ __forceinline__ void merge_top16(float (&a)[16]) {
    float c[16];
#pragma unroll
    for (int i = 0; i < 16; ++i) c[i] = fmaxf(a[i], __shfl_xor(a[15 - i], XORMASK));
#pragma unroll
    for (int j = 8; j > 0; j >>= 1)
#pragma unroll
        for (int i = 0; i < 16; ++i) { const int l = i ^ j; if (l > i) { const float hi = fmaxf(c[i], c[l]), lo = fminf(c[i], c[l]); c[i] = hi; c[l] = lo; } }
#pragma unroll
    for (int i = 0; i < 16; ++i) a[i] = c[i];
}
__device__ __forceinline__ float sel4(int g, float x0, float x1, float x2, float x3) { const float lo = (g & 1) ? x1 : x0, hi = (g & 1) ? x3 : x2; return (g & 2) ? hi : lo; }

typedef __bf16 bf2_t __attribute__((ext_vector_type(2)));
__device__ __forceinline__ float dot2bf(unsigned a, unsigned b, float c) { return __builtin_amdgcn_fdot2_f32_bf16(__builtin_bit_cast(bf2_t, a), __builtin_bit_cast(bf2_t, b), c, false); }
__device__ __forceinline__ float gelu_erf(float d) { return 0.5f * d * (1.0f + erff(d * 0.7071067811865476f)); }

typedef float f32x32v __attribute__((ext_vector_type(32)));
__device__ __forceinline__ void convert_rows_fp4(const float* __restrict__ src, unsigned char* __restrict__ dst, float* __restrict__ scales, int nrows, int gw, int ngw, int lane) {
    for (int row = gw; row < nrows; row += ngw) {
        const float* r = src + (size_t)row * 2048 + 4 * lane;
        f32x4 v[8]; float amax = 0.f;
#pragma unroll
        for (int j = 0; j < 8; ++j) { v[j] = __builtin_nontemporal_load((const f32x4*)(r + 256 * j));
            amax = fmaxf(amax, fmaxf(fmaxf(fabsf(v[j][0]), fabsf(v[j][1])), fmaxf(fabsf(v[j][2]), fabsf(v[j][3])))); }
        amax = wave_max(amax);
        const float sc = amax > 0.f ? 6.0f / amax : 1.0f;
        u32x4 w;
#pragma unroll
        for (int d = 0; d < 4; ++d) {
            unsigned x = 0;
            x = __builtin_amdgcn_cvt_scalef32_pk_fp4_f32(x, v[2 * d][0] * sc, v[2 * d][1] * sc, 1.0f, 0);
            x = __builtin_amdgcn_cvt_scalef32_pk_fp4_f32(x, v[2 * d][2] * sc, v[2 * d][3] * sc, 1.0f, 1);
            x = __builtin_amdgcn_cvt_scalef32_pk_fp4_f32(x, v[2 * d + 1][0] * sc, v[2 * d + 1][1] * sc, 1.0f, 2);
            x = __builtin_amdgcn_cvt_scalef32_pk_fp4_f32(x, v[2 * d + 1][2] * sc, v[2 * d + 1][3] * sc, 1.0f, 3);
            w[d] = x;
        }
        *(u32x4*)(dst + (size_t)row * 1024 + 16 * lane) = w;
        if (lane == 0) scales[row] = 1.0f / sc;
    }
}

__device__ __forceinline__ void dec_fp4_row(const u32x4 w, f32x2 (&o)[16]) {
#define DEC4(d) o[4 * d] = __builtin_amdgcn_cvt_scalef32_pk_f32_fp4(w[d], 1.0f, 0); o[4 * d + 1] = __builtin_amdgcn_cvt_scalef32_pk_f32_fp4(w[d], 1.0f, 1); \
                o[4 * d + 2] = __builtin_amdgcn_cvt_scalef32_pk_f32_fp4(w[d], 1.0f, 2); o[4 * d + 3] = __builtin_amdgcn_cvt_scalef32_pk_f32_fp4(w[d], 1.0f, 3);
    DEC4(0) DEC4(1) DEC4(2) DEC4(3)
#undef DEC4
}

template <int CTRL> __device__ __forceinline__ float dpp_src(float v) { return __int_as_float(__builtin_amdgcn_update_dpp(0, __float_as_int(v), CTRL, 0xF, 0xF, true)); }
__device__ __forceinline__ float reduce16_rows(const float (&d)[16], int lane) {
    float e1[8], e2[4], e3[2];
#pragma unroll
    for (int r = 0; r < 8; ++r) { const float x = d[r] + dpp_src<0x140>(d[r]), y = d[r + 8] + dpp_src<0x140>(d[r + 8]); e1[r] = (lane & 8) ? y : x; }
#pragma unroll
    for (int r = 0; r < 4; ++r) { const float x = e1[r] + dpp_src<0x141>(e1[r]), y = e1[r + 4] + dpp_src<0x141>(e1[r + 4]); e2[r] = (lane & 4) ? y : x; }
#pragma unroll
    for (int r = 0; r < 2; ++r) { const float x = e2[r] + dpp_src<0x1B>(e2[r]), y = e2[r + 2] + dpp_src<0x1B>(e2[r + 2]); e3[r] = (lane & 2) ? y : x; }
    const float x = e3[0] + dpp_src<0xB1>(e3[0]), y = e3[1] + dpp_src<0xB1>(e3[1]);
    float tot = (lane & 1) ? y : x;
    tot += __shfl_xor(tot, 16);
    tot += __shfl_xor(tot, 32);
    return tot;
}

__device__ __forceinline__ void gather_token(const Params& p, int t, int e0, int e1, float g0, float g1, int lane) {
    asm volatile("" : "+v"(lane) :: "memory");
    f32x32v hv;
    {
        const bf16_t* prow = p.PREB + (size_t)t * 2048 + 4 * lane;
        float mean, rstd;
        { const f32x2 pq = lane < 32 ? *(const f32x2*)(p.PART + (size_t)t * 64 + 2 * lane) : (f32x2){0.f, 0.f};
          mean = wave_sum(pq.x) * (1.0f / 2048.0f); const float var = fmaxf(wave_sum(pq.y) * (1.0f / 2048.0f) - mean * mean, 0.f); rstd = 1.0f / sqrtf(var + LN_EPS); }
#pragma unroll
        for (int j = 0; j < 8; ++j) {
            const u32x2 xb2 = __builtin_nontemporal_load((const u32x2*)(prow + 256 * j));
            const f32x4 x = (f32x4){__uint_as_float(xb2.x << 16), __uint_as_float(xb2.x & 0xffff0000u), __uint_as_float(xb2.y << 16), __uint_as_float(xb2.y & 0xffff0000u)};
            const f32x4 gg = *(const f32x4*)(p.ln1_g + 4 * lane + 256 * j), bb = *(const f32x4*)(p.ln1_b + 4 * lane + 256 * j);
            const f32x4 hh = (x - mean) * rstd * gg + bb;
            hv[4 * j] = hh[0]; hv[4 * j + 1] = hh[1]; hv[4 * j + 2] = hh[2]; hv[4 * j + 3] = hh[3];
        }
    }
    const float us0 = p.US[e0], us1 = p.US[e1], vs0 = p.VS[e0], vs1 = p.VS[e1];
    float c0 = 0.f, c1 = 0.f;
    u32x4 rb[4][4];
#define PG_ROW(TAB, PICK) (*(const u32x4*)((TAB) + (size_t)__builtin_amdgcn_readlane((PICK) < 64 ? e0 : e1, (PICK) & 63) * 1024 + 16 * lane))
#pragma unroll
    for (int q = 0; q < 4; ++q)
#pragma unroll
        for (int r = 0; r < 4; ++r) rb[q][r] = PG_ROW(p.U8, 4 * q + r);
#pragma unroll 1
    for (int it = 0; it < 8; ++it) {
        const unsigned char* ntab = it < 7 ? p.U8 : p.V8;
        float dd[16];
#pragma unroll
        for (int q = 0; q < 4; ++q) {
            const int pp = 16 * it + 4 * q;
#pragma unroll
            for (int r = 0; r < 4; ++r) {
                f32x2 da = (f32x2){0.f, 0.f}, db = (f32x2){0.f, 0.f}, uv[16];
                dec_fp4_row(rb[q][r], uv);
#pragma unroll
                for (int k = 0; k < 32; k += 4) {
                    da = __builtin_elementwise_fma(uv[k >> 1], (f32x2){hv[k], hv[k + 1]}, da);
                    db = __builtin_elementwise_fma(uv[(k >> 1) + 1], (f32x2){hv[k + 2], hv[k + 3]}, db);
                }
                dd[4 * q + r] = (da.x + da.y) + (db.x + db.y);
            }
#pragma unroll
            for (int r = 0; r < 4; ++r) rb[q][r] = PG_ROW(ntab, (pp + 16 + r) & 127);
        }
        const float tot = reduce16_rows(dd, lane);
        if ((lane >> 4) == (it & 3)) { if (it < 4) c0 = tot; else c1 = tot; }
    }
    c0 = gelu_erf(c0 * us0) * g0 * vs0; c1 = gelu_erf(c1 * us1) * g1 * vs1;
    f32x32v acc;
#pragma unroll
    for (int k = 0; k < 32; ++k) acc[k] = 0.f;
#pragma unroll 1
    for (int it = 0; it < 8; ++it) {
#pragma unroll
        for (int q = 0; q < 4; ++q) {
            const int pp = 16 * it + 4 * q;
#pragma unroll
            for (int r = 0; r < 4; ++r) {
                const float cf = __uint_as_float(__builtin_amdgcn_readlane(__float_as_uint(pp < 64 ? c0 : c1), (pp + r) & 63));
                const f32x2 cf2 = (f32x2){cf, cf};
                f32x2 vv[16];
                dec_fp4_row(rb[q][r], vv);
#pragma unroll
                for (int k = 0; k < 32; k += 2) {
                    const f32x2 a2 = __builtin_elementwise_fma(vv[k >> 1], cf2, (f32x2){acc[k], acc[k + 1]});
                    acc[k] = a2.x; acc[k + 1] = a2.y;
                }
            }
            if (it < 7) {
#pragma unroll
                for (int r = 0; r < 4; ++r) rb[q][r] = PG_ROW(p.V8, pp + 16 + r);
            }
        }
    }
#undef PG_ROW
    float s = 0.f;
#pragma unroll
    for (int k = 0; k < 32; ++k) { acc[k] = acc[k] + ALPHA * hv[k]; s += acc[k]; }
    const float mean2 = wave_sum(s) * (1.0f / 2048.0f);
    float q2 = 0.f;
#pragma unroll
    for (int k = 0; k < 32; ++k) { acc[k] = acc[k] - mean2; q2 = fmaf(acc[k], acc[k], q2); }
    const float rstd2 = 1.0f / sqrtf(wave_sum(q2) * (1.0f / 2048.0f) + LN_EPS);
    float* orow = p.out + (size_t)t * 2048 + 4 * lane;
#pragma unroll
    for (int j = 0; j < 8; ++j) {
        const f32x4 g = *(const f32x4*)(p.ln2_g + 4 * lane + 256 * j), bb = *(const f32x4*)(p.ln2_b + 4 * lane + 256 * j);
        const f32x4 a4 = (f32x4){acc[4 * j], acc[4 * j + 1], acc[4 * j + 2], acc[4 * j + 3]};
        __builtin_nontemporal_store(a4 * rstd2 * g + bb, (f32x4*)(orow + 256 * j));
    }
}

__device__ __forceinline__ void phase_select_gather_impl(const Params& p, LAS unsigned char* lds) {
    constexpr int CA[52] = {0, 0, 0, 0, 0, 0, 0, 0, 0, 0, 0, 0, 0, 0, 0, 0, 1, 1, 1, 1, 1, 1, 1, 1, 2, 2, 2, 2, 2, 3, 3, 3, 3, 4, 4, 4, 5, 5, 6, 6, 7, 7, 8, 9, 10, 11, 12, 13, 14, 15, -1, -1};
    constexpr int CB[52] = {0, 1, 2, 3, 4, 5, 6, 7, 8, 9, 10, 11, 12, 13, 14, 15, 0, 1, 2, 3, 4, 5, 6, 7, 0, 1, 2, 3, 4, 0, 1, 2, 3, 0, 1, 2, 0, 1, 0, 1, 0, 1, 0, 0, 0, 0, 0, 0, 0, 0, -1, -1};
    constexpr int L_KEYS = 0;
    constexpr int L_TAB = 69632;
    constexpr int L_SCR = 69632 + 128;
    constexpr int L_PK = L_SCR + 8 * 2048;
    int tid_ = threadIdx.x; asm volatile("" : "+v"(tid_) :: "memory");
    const int tid = tid_, wave = tid >> 6, lane = tid & 63, n16 = lane & 15, g = lane >> 4;
    for (int i = tid; i < 2 * 128 * 16; i += NTHREADS) {
        const int row = i >> 4, c8 = i & 15;
        const f32x4 a = *(const f32x4*)(p.peer_keys + (size_t)row * 128 + c8 * 8), b = *(const f32x4*)(p.peer_keys + (size_t)row * 128 + c8 * 8 + 4);
        u32x4 o; o.x = cvt_pk_bf16(a[0], a[1]); o.y = cvt_pk_bf16(a[2], a[3]); o.z = cvt_pk_bf16(b[0], b[1]); o.w = cvt_pk_bf16(b[2], b[3]);
        *(LAS u32x4*)(lds + L_KEYS + row * 272 + c8 * 16) = o;
    }
    if (tid < 52) {
        int a = 0, b = 0;
#pragma unroll
        for (int c = 0; c < 52; ++c) if (tid == c) { a = CA[c] < 0 ? 0 : CA[c]; b = CB[c] < 0 ? 0 : CB[c]; }
        *(LAS unsigned char*)(lds + L_TAB + tid) = (unsigned char)a; *(LAS unsigned char*)(lds + L_TAB + 64 + tid) = (unsigned char)b;
    }
    __syncthreads();
    LAS float* scr = (LAS float*)(lds + L_SCR + wave * 2048);
    const int gw = blockIdx.x * 8 + wave, NGW = gridDim.x * 8;
    const int ntask = (T * 8 / 16 - gw + NGW - 1) / NGW;
    const bool typeB = (wave & 1) != 0;
#pragma unroll 1
    for (int j = 0; j < 2 * ntask; ++j) {
        const int ti = j >> 1, sub = j & 1;
        int selTask = -1;
        if (!typeB) { if (sub == 0) selTask = ti; }
        else { if (j == 0) selTask = 0; else if (sub == 1 && ti + 1 < ntask) selTask = ti + 1; }
        if (selTask >= 0) {
        int lane_s = lane; asm volatile("" : "+v"(lane_s) :: "memory");
        const int n16 = lane_s & 15, g = lane_s >> 4;
        const int task = gw + selTask * NGW;
        LAS int* pkidx = (LAS int*)(lds + L_PK + wave * 4096 + (selTask & 1) * 2048);
        LAS float* pkgate = (LAS float*)(lds + L_PK + wave * 4096 + (selTask & 1) * 2048 + 1024);
        const int item = task * 16 + n16, t = item >> 3, hd = item & 7;
        float sv[2][16];
#pragma unroll
        for (int pp = 0; pp < 2; ++pp) {
            bf16x8 qf[4];
            const bf16_t* qrow = p.QP + (size_t)t * 2048 + hd * 256 + pp * 128 + 8 * g;
#pragma unroll
            for (int ks = 0; ks < 4; ++ks) qf[ks] = __builtin_nontemporal_load((const bf16x8*)(qrow + 32 * ks));
            float v[32];
#pragma unroll
            for (int kt = 0; kt < 8; ++kt) {
                f32x4 acc = (f32x4){0.f, 0.f, 0.f, 0.f};
#pragma unroll
                for (int ks = 0; ks < 4; ++ks) {
                    const bf16x8 kf = *(const LAS bf16x8*)(lds + L_KEYS + (pp * 128 + 16 * kt + n16) * 272 + ks * 64 + g * 16);
                    acc = mfma16(kf, qf[ks], acc);
                }
#pragma unroll
                for (int rr = 0; rr < 4; ++rr) v[4 * kt + rr] = __uint_as_float((__float_as_uint(acc[rr]) & 0xFFFFFF80u) | (unsigned)(16 * kt + 4 * g + rr));
            }
            sort_desc<32>(v);
            float top[16];
#pragma unroll
            for (int r = 0; r < 16; ++r) top[r] = v[r];
            merge_top16<16>(top); merge_top16<32>(top);
#pragma unroll
            for (int r = 0; r < 16; ++r) sv[pp][r] = top[r];
        }
        if (g == 0) {
#pragma unroll
            for (int r = 0; r < 16; ++r) { scr[n16 * 32 + r] = sv[0][r]; scr[n16 * 32 + 16 + r] = sv[1][r]; }
        }
        float cs[16];
#pragma unroll
        for (int s = 0; s < 13; ++s) {
            const int c0 = 4 * s;
            const float a = sel4(g, sv[0][CA[c0] < 0 ? 0 : CA[c0]], sv[0][CA[c0 + 1] < 0 ? 0 : CA[c0 + 1]], sv[0][CA[c0 + 2] < 0 ? 0 : CA[c0 + 2]], sv[0][CA[c0 + 3] < 0 ? 0 : CA[c0 + 3]]);
            const float b = sel4(g, sv[1][CB[c0] < 0 ? 0 : CB[c0]], sv[1][CB[c0 + 1] < 0 ? 0 : CB[c0 + 1]], sv[1][CB[c0 + 2] < 0 ? 0 : CB[c0 + 2]], sv[1][CB[c0 + 3] < 0 ? 0 : CB[c0 + 3]]);
            float sum = __uint_as_float((__float_as_uint(a + b) & 0xFFFFFFC0u) | (unsigned)(c0 + g));
            if (s == 12) sum = (g >= 2) ? -INFINITY : sum;
            cs[s] = sum;
        }
        cs[13] = -INFINITY; cs[14] = -INFINITY; cs[15] = -INFINITY;
        sort_desc<16>(cs);
        merge_top16<16>(cs); merge_top16<32>(cs);
        float ts[16];
#pragma unroll
        for (int r = 0; r < 16; ++r) ts[r] = cs[r];
        float den = 0.f, e[16];
#pragma unroll
        for (int r = 0; r < 16; ++r) { e[r] = __expf(ts[r] - ts[0]); den += e[r]; }
        const float inv = 1.0f / den;
#pragma unroll
        for (int k = 0; k < 4; ++k) {
            const float tv = sel4(g, ts[k], ts[4 + k], ts[8 + k], ts[12 + k]);
            const float ev = sel4(g, e[k], e[4 + k], e[8 + k], e[12 + k]);
            const int c = (int)(__float_as_uint(tv) & 63u);
            const int a = *(const LAS unsigned char*)(lds + L_TAB + c), b = *(const LAS unsigned char*)(lds + L_TAB + 64 + c);
            const int e0 = (int)(__float_as_uint(scr[n16 * 32 + a]) & 127u), e1 = (int)(__float_as_uint(scr[n16 * 32 + 16 + b]) & 127u);
            const int oi = (n16 >> 3) * 128 + hd * 16 + 4 * g + k;
            pkidx[oi] = e0 * 128 + e1;
            pkgate[oi] = ev * inv;
        }
        asm volatile("s_waitcnt lgkmcnt(0)" ::: "memory");
        }
        {
            const LAS int* gidx = (const LAS int*)(lds + L_PK + wave * 4096 + (ti & 1) * 2048);
            const LAS float* ggate = (const LAS float*)(lds + L_PK + wave * 4096 + (ti & 1) * 2048 + 1024);
            const int ge0 = gidx[sub * 128 + lane], ge1 = gidx[sub * 128 + 64 + lane];
            const float gg0 = ggate[sub * 128 + lane], gg1 = ggate[sub * 128 + 64 + lane];
            gather_token(p, (gw + ti * NGW) * 2 + sub, ge0, ge1, gg0, gg1, lane);
        }
        asm volatile("s_waitcnt lgkmcnt(0)" ::: "memory");
    }
    __syncthreads();
}

__global__ void __launch_bounds__(NTHREADS, 2) mega(Params p) {
    extern __shared__ __attribute__((aligned(16))) unsigned char dyn_lds[];
    LAS unsigned char* lds = (LAS unsigned char*)dyn_lds;
    cg::grid_group grid = cg::this_grid();
    const int G = gridDim.x;
    volatile LAS unsigned* xbw = (volatile LAS unsigned*)(lds + LDS_BYTES - 16);
    if (threadIdx.x == 0) { xbw[0] = 0u; xbw[1] = 0u; }
    __syncthreads();
    const XcdBarrier xb = xcd_barrier_post(p.BAR, xbw);
    phase_prep(p, lds);
    xcd_barrier(xb);
    { pg8::Gemm g{p.R, p.R, D}; pg8::ProjOrder so; so.init(G, blockIdx.x);
      pg8::EpiProj E{p.AQ, p.AK, p.AVT, p.DQ, p.DK, p.DV, p.DZ, p.BG};
      pg8::gemm_phase(lds, g, so, E); }
    xcd_barrier(xb);
    phase_dnprep<0>(p, lds);
    xcd_barrier(xb);
    if (blockIdx.x < 64) phase_dnscan(p, lds);
    else {
        phase_dnprep<1>(p, lds);
        phase_attn(p, lds, blockIdx.x - 64, G - 64);
        phase_prep_late(p, lds, blockIdx.x - 64, G - 64);
        int tid_ = threadIdx.x; asm volatile("" : "+v"(tid_) :: "memory");
        const int wave = tid_ >> 6, lane = tid_ & 63, gw = (blockIdx.x - 64) * 8 + wave, ngw = (G - 64) * 8;
        convert_rows_fp4(p.peer_u, p.U8, p.US, 16384, gw, ngw, lane);
        convert_rows_fp4(p.peer_v, p.V8, p.VS, 16384, gw, ngw, lane);
    }
    grid.sync();
    phase_dncombine(p);
    xcd_barrier(xb);
    { pg8::Gemm g{p.MIX, p.WOUTT, D}; pg8::StaticOrder so; so.init(64, 8, G, blockIdx.x);
      pg8::EpiResBf16 E{p.PREB, p.x, D, ALPHA, p.PART};
      pg8::gemm_phase(lds, g, so, E); }
    xcd_barrier(xb);
    { pg8::Gemm g{p.PREB, p.WQT, D}; pg8::StaticOrder so; so.init(64, 8, G, blockIdx.x);
      pg8::EpiLnQ E{p.QP, D, p.PART, p.CS, p.BW};
      pg8::gemm_phase(lds, g, so, E); }
    xcd_barrier(xb);
    phase_select_gather_impl(p, lds);
}
}

extern "C" void kernel_launch(void* const* d_in, const int* in_sizes, int n_in, void* d_out, int out_size, void* d_ws, size_t ws_size, hipStream_t stream) {
    if (n_in != 17 || out_size != T * D || ws_size < 500 * MB) { fprintf(stderr, "kernel_launch: unexpected sizes n_in %d out %d ws %zu\n", n_in, out_size, ws_size); return; }
    static int grid_blocks = 0;
    if (!grid_blocks) {
        int dev = 0, cus = 0, per_cu = 0;
        (void)hipGetDevice(&dev);
        (void)hipDeviceGetAttribute(&cus, hipDeviceAttributeMultiprocessorCount, dev);
        if (hipFuncSetAttribute((const void*)mega, hipFuncAttributeMaxDynamicSharedMemorySize, LDS_BYTES) != hipSuccess) fprintf(stderr, "kernel_launch: hipFuncSetAttribute failed\n");
        (void)hipOccupancyMaxActiveBlocksPerMultiprocessor(&per_cu, (const void*)mega, NTHREADS, LDS_BYTES);
        if (per_cu < 1) { fprintf(stderr, "kernel_launch: occupancy query says %d\n", per_cu); per_cu = 1; }
        grid_blocks = cus;
        fprintf(stderr, "kernel_launch: cus %d per_cu %d grid %d\n", cus, per_cu, grid_blocks);
    }
    char* ws = (char*)d_ws;
    Params p;
    memset(&p, 0, sizeof(p));
    p.x = (const float*)d_in[0]; p.w_in = (const float*)d_in[1]; p.conv_w = (const float*)d_in[2]; p.a_log = (const float*)d_in[3]; p.dt_bias = (const float*)d_in[4];
    p.dn_norm_w = (const float*)d_in[5]; p.attn_sink = (const float*)d_in[6]; p.rel_bias = (const float*)d_in[7]; p.w_out = (const float*)d_in[8];
    p.ln1_g = (const float*)d_in[9]; p.ln1_b = (const float*)d_in[10]; p.peer_wq = (const float*)d_in[11]; p.peer_keys = (const float*)d_in[12];
    p.peer_u = (const float*)d_in[13]; p.peer_v = (const float*)d_in[14]; p.ln2_g = (const float*)d_in[15]; p.ln2_b = (const float*)d_in[16];
    p.out = (float*)d_out;
    p.R = (bf16_t*)(ws + 0 * MB);
    p.AQ = (bf16_t*)(ws + 88 * MB);
    p.AK = (bf16_t*)(ws + 120 * MB);
    p.AVT = (bf16_t*)(ws + 128 * MB);
    p.DQ = (bf16_t*)(ws + 136 * MB);
    p.DK = (bf16_t*)(ws + 168 * MB);
    p.DV = (bf16_t*)(ws + 200 * MB);
    p.DZ = (bf16_t*)(ws + 232 * MB);
    p.BG = (float*)(ws + 264 * MB);
    p.WOUTT = (bf16_t*)(ws + 266 * MB);
    p.WQT = (bf16_t*)(ws + 274 * MB);
    p.MIX = (bf16_t*)(ws + 0 * MB);
    p.DND = (unsigned char*)(ws + 282 * MB);
    p.DNS = (unsigned char*)d_out + 64 * MB;
    p.OF = (bf16_t*)d_out;
    p.OB = (bf16_t*)((char*)d_out + 32 * MB);
    p.PREB = (bf16_t*)(ws + 282 * MB);
    p.HB = (bf16_t*)(ws + 0 * MB);
    p.QP = (bf16_t*)(ws + 66 * MB);
    p.EIDX = (int*)(ws + 346 * MB);
    p.GATE = (float*)(ws + 354 * MB);
    p.V8 = (unsigned char*)(ws + 446 * MB);
    p.U8 = (unsigned char*)(ws + 462 * MB);
    p.US = (float*)(ws + 478 * MB);
    p.VS = (float*)(ws + 479 * MB);
    p.PART = (float*)(ws + 202 * MB);
    p.PCS = (float*)(ws + 480 * MB);
    p.PBW = (float*)(ws + 481 * MB);
    p.CS = (float*)(ws + 208 * MB);
    p.BW = (float*)(ws + 208 * MB + 16384);
    p.BAR = (unsigned*)(ws + 490 * MB);
    p.FLAG = p.BAR + 4096;
    (void)hipMemsetAsync(p.BAR, 0, (4096 + 2048) * 4, stream);
    void* args[] = {&p};
    hipError_t e = hipLaunchCooperativeKernel((const void*)mega, dim3(grid_blocks), dim3(NTHREADS), args, LDS_BYTES, stream);
    if (e != hipSuccess) fprintf(stderr, "cooperative launch failed: %s (grid %d)\n", hipGetErrorString(e), grid_blocks);
}
```

```cpp
#include <hip/hip_runtime.h>
#include <hip/hip_cooperative_groups.h>
#include <cstdio>
#include <cstdint>
#include <cmath>
#include <cstring>

namespace {
namespace cg = cooperative_groups;
#define LAS __attribute__((address_space(3)))
typedef unsigned short bf16_t;
typedef short bf16x8 __attribute__((ext_vector_type(8)));
typedef float f32x4 __attribute__((ext_vector_type(4)));
typedef float f32x2 __attribute__((ext_vector_type(2)));
typedef unsigned u32x4 __attribute__((ext_vector_type(4)));
typedef unsigned u32x2 __attribute__((ext_vector_type(2)));

constexpr int D = 2048, NB = 4, S = 4096, T = NB * S;
constexpr int INW = 5664;
constexpr float ALPHA = 1.189207115002721f;
constexpr float LN_EPS = 1e-5f, RMS_EPS = 1e-6f;
constexpr size_t MB = 1024ull * 1024ull;
constexpr int NTHREADS = 512;
constexpr int LDS_BYTES = 134 * 1024;

__device__ __forceinline__ float wave_sum(float v) {
#pragma unroll
    for (int o = 1; o < 64; o <<= 1) v += __shfl_xor(v, o);
    return v;
}
__device__ __forceinline__ float wave_max(float v) {
#pragma unroll
    for (int o = 1; o < 64; o <<= 1) v = fmaxf(v, __shfl_xor(v, o));
    return v;
}
__device__ __forceinline__ float silu_f(float x) { return x * __builtin_amdgcn_rcpf(1.0f + __builtin_amdgcn_exp2f(-1.4426950408889634f * x)); }
__device__ __forceinline__ float sigmoid_f(float x) { return 1.0f / (1.0f + expf(-x)); }
__device__ __forceinline__ float softplus_f(float x) { return fmaxf(x, 0.f) + log1pf(expf(-fabsf(x))); }
__device__ __forceinline__ float bf2f(bf16_t v) { return __uint_as_float(((unsigned)v) << 16); }
__device__ __forceinline__ float ldf(const float* p) { return *p; }
__device__ __forceinline__ float ldf(const bf16_t* p) { return bf2f(*p); }
typedef __bf16 bf16x2_t __attribute__((ext_vector_type(2)));
__device__ __forceinline__ unsigned cvt_pk_bf16(float lo, float hi) { const f32x2 v = {lo, hi}; return __builtin_bit_cast(unsigned, __builtin_convertvector(v, bf16x2_t)); }
__device__ __forceinline__ bf16_t f2bf(float f) { return (bf16_t)(cvt_pk_bf16(f, 0.f) & 0xffffu); }
__device__ __forceinline__ int t5_bucket(int rel) {
    int n = rel < 0 ? -rel : rel;
    int v;
    if (n < 8) v = n; else if (n < 12) v = 8; else if (n < 16) v = 9; else if (n < 23) v = 10; else if (n < 32) v = 11;
    else if (n < 46) v = 12; else if (n < 64) v = 13; else if (n < 91) v = 14; else v = 15;
    return v + (rel > 0 ? 16 : 0);
}

namespace pg8 {
constexpr int BM = 256, BK = 64, HALF = 128, HTB = HALF * BK * 2, STAGE_BYTES = 8 * HTB, NXCD = 8, WGM = 8;
__host__ __device__ __forceinline__ int lds_byte(int r, int c) { const int st = (r >> 4) * 2 + (c >> 5), rr = r & 15, cc = c & 31, ob = rr * 64 + cc * 2; return st * 1024 + (ob ^ (((ob >> 9) & 1) << 5)); }
__host__ __device__ __forceinline__ void stage_rc(int b, int& R, int& C) { const int st = b / 1024, sb = b % 1024, swz = sb ^ (((sb >> 9) & 1) << 5); R = (st >> 1) * 16 + swz / 64; C = (st & 1) * 32 + (swz % 64) / 2; }
__host__ __device__ __forceinline__ int perm32(int rho) { const int n = rho >> 4, i = rho & 15; return 8 * (i >> 2) + 4 * n + (i & 3); }
struct Unit { int pm, pn; };
struct Gemm { const bf16_t* A; const bf16_t* Bt; int K; };
struct StaticOrder {
    int nM, nN, nwg, G, c;
    __device__ void init(int nM_, int nN_, int G_, int c_) { nM = nM_; nN = nN_; nwg = nM * nN; G = G_; c = c_; }
    __device__ bool next(int i, Unit& u) const {
        const long L = (long)i * G + c; if (L >= nwg) return false;
        int wgid = (int)L; { const int q = nwg / NXCD, r = nwg % NXCD, xcd = wgid % NXCD, off = wgid / NXCD; wgid = (xcd < r ? xcd * (q + 1) : r * (q + 1) + (xcd - r) * q) + off; }
        const int nig = WGM * nN, gid = wgid / nig, fm = gid * WGM, gsz = (nM - fm) < WGM ? (nM - fm) : WGM;
        u.pm = fm + ((wgid % nig) % gsz); u.pn = (wgid % nig) / gsz; return true;
    }
};
struct ProjOrder {
    StaticOrder so; int G, c;
    __device__ void init(int G_, int c_) { so.init(64, 22, G_, c_); G = G_; c = c_; }
    __device__ bool next(int i, Unit& u) const {
        const long L = (long)i * G + c;
        if (L < 1408) { so.next(i, u); u.pn = 64 + (u.pn < 5 ? u.pn : u.pn + 1); return true; }
        if (L < 1472) { u.pm = 69; u.pn = (int)(L - 1408); return true; }
        return false;
    }
};

struct EpiProj {
    static constexpr bool PERM = true, HAS_PRE = false;
    bf16_t *AQ, *AK, *AVT, *DQ, *DK, *DV, *DZ; float* BG;
    __device__ __forceinline__ void operator()(const f32x4 (&acc)[2][2][4][2], const Unit& u, int wr, int wc, int fr, int fq) const {
        bf16_t* base; int ldc; int colt; int rowt;
        if (u.pm == 69) { base = AVT; ldc = T; colt = u.pn * BM; rowt = 0; }
        else {
            rowt = u.pm * BM; const int wt = u.pn - 64;
            if (wt == 22) {
                if (wc == 0) {
#pragma unroll
                    for (int ai = 0; ai < 2; ++ai)
#pragma unroll
                        for (int m = 0; m < 4; ++m) { float* rowp = BG + (size_t)(rowt + ai * HALF + wr * 64 + m * 16 + fr) * 32 + 8 * fq;
                            *(f32x4*)(rowp) = acc[ai][0][m][0]; *(f32x4*)(rowp + 4) = acc[ai][0][m][1]; }
                }
                return;
            }
            if (wt < 4) { base = AQ; ldc = 1024; colt = wt * 256; }
            else if (wt == 4) { base = AK; ldc = 256; colt = 0; }
            else if (wt < 10) { base = DQ; ldc = 1024; colt = (wt - 6) * 256; }
            else if (wt < 14) { base = DK; ldc = 1024; colt = (wt - 10) * 256; }
            else if (wt < 18) { base = DV; ldc = 1024; colt = (wt - 14) * 256; }
            else { base = DZ; ldc = 1024; colt = (wt - 18) * 256; }
        }
        const int row0 = rowt + wr * 64 + fr, col0 = colt + wc * 32 + 8 * fq;
#pragma unroll
        for (int ai = 0; ai < 2; ++ai)
#pragma unroll
            for (int m = 0; m < 4; ++m) { bf16_t* rowp = base + (size_t)(row0 + ai * HALF + m * 16) * ldc + col0;
#pragma unroll
                for (int bj = 0; bj < 2; ++bj) { const f32x4 v0 = acc[ai][bj][m][0], v1 = acc[ai][bj][m][1];
                    u32x4 w; w.x = cvt_pk_bf16(v0[0], v0[1]); w.y = cvt_pk_bf16(v0[2], v0[3]); w.z = cvt_pk_bf16(v1[0], v1[1]); w.w = cvt_pk_bf16(v1[2], v1[3]);
                    *(u32x4*)(rowp + bj * HALF) = w; } }
    }
};
struct EpiBf16 {
    static constexpr bool PERM = true, HAS_PRE = false;
    bf16_t* O; int ldc;
    __device__ __forceinline__ void operator()(const f32x4 (&acc)[2][2][4][2], const Unit& u, int wr, int wc, int fr, int fq) const {
        const int row0 = u.pm * BM + wr * 64 + fr, col0 = u.pn * BM + wc * 32 + 8 * fq;
#pragma unroll
        for (int ai = 0; ai < 2; ++ai)
#pragma unroll
            for (int m = 0; m < 4; ++m) { bf16_t* rowp = O + (size_t)(row0 + ai * HALF + m * 16) * ldc + col0;
#pragma unroll
                for (int bj = 0; bj < 2; ++bj) { const f32x4 v0 = acc[ai][bj][m][0], v1 = acc[ai][bj][m][1];
                    u32x4 w; w.x = cvt_pk_bf16(v0[0], v0[1]); w.y = cvt_pk_bf16(v0[2], v0[3]); w.z = cvt_pk_bf16(v1[0], v1[1]); w.w = cvt_pk_bf16(v1[2], v1[3]);
                    *(u32x4*)(rowp + bj * HALF) = w; } }
    }
};
struct EpiResF32 {
    static constexpr bool PERM = false, HAS_PRE = false;
    float* C; const float* X; int ldc; float alpha;
    __device__ __forceinline__ void operator()(const f32x4 (&acc)[2][2][4][2], const Unit& u, int wr, int wc, int fr, int fq) const {
        const int row0 = u.pm * BM + wr * 64 + fr, col0 = u.pn * BM + wc * 32 + 4 * fq;
        const float* __restrict__ Xr = X; float* __restrict__ Cr = C;
#pragma unroll
        for (int ai = 0; ai < 2; ++ai)
#pragma unroll
            for (int mp = 0; mp < 2; ++mp) {
                f32x4 xv[2][2][2];
#pragma unroll
                for (int mq = 0; mq < 2; ++mq) { const size_t off = (size_t)(row0 + ai * HALF + (2 * mp + mq) * 16) * ldc + col0;
#pragma unroll
                    for (int bj = 0; bj < 2; ++bj)
#pragma unroll
                        for (int n = 0; n < 2; ++n) xv[mq][bj][n] = __builtin_nontemporal_load((const f32x4*)(Xr + off + bj * HALF + n * 16)); }
#pragma unroll
                for (int mq = 0; mq < 2; ++mq) { const size_t off = (size_t)(row0 + ai * HALF + (2 * mp + mq) * 16) * ldc + col0;
#pragma unroll
                    for (int bj = 0; bj < 2; ++bj)
#pragma unroll
                        for (int n = 0; n < 2; ++n) *(f32x4*)(Cr + off + bj * HALF + n * 16) = acc[ai][bj][2 * mp + mq][n] + alpha * xv[mq][bj][n]; }
                asm volatile("" ::: "memory"); }
    }
};

struct EpiResBf16 {
    static constexpr bool PERM = true, HAS_PRE = false;
    bf16_t* O; const float* X; int ldc; float alpha; float* PART;
    __device__ __forceinline__ void operator()(const f32x4 (&acc)[2][2][4][2], const Unit& u, int wr, int wc, int fr, int fq) const {
        const int row0 = u.pm * BM + wr * 64 + fr, col0 = u.pn * BM + wc * 32 + 8 * fq;
        const float* __restrict__ Xr = X; bf16_t* __restrict__ Or = O;
#pragma unroll
        for (int ai = 0; ai < 2; ++ai)
#pragma unroll
            for (int mp = 0; mp < 2; ++mp) {
                f32x4 xv[2][2][2];
#pragma unroll
                for (int mq = 0; mq < 2; ++mq) { const size_t off = (size_t)(row0 + ai * HALF + (2 * mp + mq) * 16) * ldc + col0;
#pragma unroll
                    for (int bj = 0; bj < 2; ++bj) { xv[mq][bj][0] = __builtin_nontemporal_load((const f32x4*)(Xr + off + bj * HALF)); xv[mq][bj][1] = __builtin_nontemporal_load((const f32x4*)(Xr + off + bj * HALF + 4)); } }
#pragma unroll
                for (int mq = 0; mq < 2; ++mq) { const int row = row0 + ai * HALF + (2 * mp + mq) * 16; const size_t off = (size_t)row * ldc + col0;
                    float s1 = 0.f, s2 = 0.f;
#pragma unroll
                    for (int bj = 0; bj < 2; ++bj) { const f32x4 v0 = acc[ai][bj][2 * mp + mq][0] + alpha * xv[mq][bj][0], v1 = acc[ai][bj][2 * mp + mq][1] + alpha * xv[mq][bj][1];
                        u32x4 w; w.x = cvt_pk_bf16(v0[0], v0[1]); w.y = cvt_pk_bf16(v0[2], v0[3]); w.z = cvt_pk_bf16(v1[0], v1[1]); w.w = cvt_pk_bf16(v1[2], v1[3]);
                        *(u32x4*)(Or + off + bj * HALF) = w;
#pragma unroll
                        for (int e = 0; e < 4; ++e) { const float lo = __uint_as_float(w[e] << 16), hi = __uint_as_float(w[e] & 0xffff0000u); s1 += lo + hi; s2 = fmaf(lo, lo, s2); s2 = fmaf(hi, hi, s2); } }
                    s1 += __shfl_xor(s1, 16); s1 += __shfl_xor(s1, 32); s2 += __shfl_xor(s2, 16); s2 += __shfl_xor(s2, 32);
                    if (fq == 0) *(f32x2*)(PART + (size_t)row * 64 + (u.pn * 4 + wc) * 2) = (f32x2){s1, s2}; }
                asm volatile("" ::: "memory"); }
    }
};
struct EpiLnQ {
    static constexpr bool PERM = true, HAS_PRE = true;
    bf16_t* O; int ldc; const float* PART; const float* CS; const float* BW;
    __device__ __forceinline__ void pre(LAS unsigned char* lds, const Unit& u, int ui) const {
        int tid = threadIdx.x; asm volatile("" : "+v"(tid));
        LAS float* tab = (LAS float*)(lds + STAGE_BYTES + (ui & 1) * 2048);
        if (tid < 256) {
            const f32x4* pp = (const f32x4*)(PART + (size_t)(u.pm * BM + tid) * 64);
            float s1 = 0.f, s2 = 0.f;
#pragma unroll
            for (int i = 0; i < 16; ++i) { const f32x4 v = pp[i]; s1 += v[0] + v[2]; s2 += v[1] + v[3]; }
            const float mean = s1 * (1.0f / 2048.0f), var = fmaxf(s2 * (1.0f / 2048.0f) - mean * mean, 0.f);
            tab[2 * tid] = mean; tab[2 * tid + 1] = 1.0f / sqrtf(var + 1e-5f);
        }
        asm volatile("s_waitcnt lgkmcnt(0)" ::: "memory"); __builtin_amdgcn_s_barrier(); asm volatile("" ::: "memory");
    }
    __device__ __forceinline__ void run(LAS unsigned char* lds, int ui, const f32x4 (&acc)[2][2][4][2], const Unit& u, int wr, int wc, int fr, int fq) const {
        const LAS f32x2* tab = (const LAS f32x2*)(lds + STAGE_BYTES + (ui & 1) * 2048);
        const int rl0 = wr * 64 + fr, col0 = u.pn * BM + wc * 32 + 8 * fq;
        f32x4 cs[2][2], bw[2][2];
#pragma unroll
        for (int bj = 0; bj < 2; ++bj)
#pragma unroll
            for (int n = 0; n < 2; ++n) { cs[bj][n] = *(const f32x4*)(CS + col0 + bj * HALF + 4 * n); bw[bj][n] = *(const f32x4*)(BW + col0 + bj * HALF + 4 * n); }
#pragma unroll
        for (int ai = 0; ai < 2; ++ai)
#pragma unroll
            for (int m = 0; m < 4; ++m) { const int rl = rl0 + ai * HALF + m * 16; const f32x2 st = tab[rl]; bf16_t* rowp = O + (size_t)(u.pm * BM + rl) * ldc + col0;
#pragma unroll
                for (int bj = 0; bj < 2; ++bj) { const f32x4 v0 = (acc[ai][bj][m][0] - st.x * cs[bj][0]) * st.y + bw[bj][0], v1 = (acc[ai][bj][m][1] - st.x * cs[bj][1]) * st.y + bw[bj][1];
                    u32x4 w; w.x = cvt_pk_bf16(v0[0], v0[1]); w.y = cvt_pk_bf16(v0[2], v0[3]); w.z = cvt_pk_bf16(v1[0], v1[1]); w.w = cvt_pk_bf16(v1[2], v1[3]);
                    *(u32x4*)(rowp + bj * HALF) = w; } }
    }
};

template <class Epi, class Sched>
__device__ __forceinline__ void gemm_phase(LAS unsigned char* lds, const Gemm g, const Sched& S, const Epi& E) {
    int tid_ = threadIdx.x; asm volatile("" : "+v"(tid_) :: "memory");
    const int tid = tid_, wid = __builtin_amdgcn_readfirstlane(tid >> 6), lane = tid & 63, wr = wid >> 2, wc = wid & 3, fr = lane & 15, fq = lane >> 4;
    const int K = g.K, nt = K / BK;
    unsigned voffA[2], voffB[2];
#pragma unroll
    for (int i = 0; i < 2; ++i) { int R, C; stage_rc(tid * 16 + i * 8192, R, C); const int Rb = Epi::PERM ? ((R & ~31) + perm32(R & 31)) : R;
        voffA[i] = (unsigned)(R * K + C) * 2u; voffB[i] = (unsigned)(Rb * K + C) * 2u; }
    const size_t kstep = (size_t)(BK * 2);
    const size_t hstep = (size_t)HALF * K * 2;
    const size_t tstep = 2 * hstep;
    const unsigned ldsw = (unsigned)wid * 1024u;
    const int aoff = lds_byte(wr * 64 + fr, fq * 8), boff = lds_byte(wc * 32 + fr, fq * 8);
#define PG8_SA(b, h) (((b) * 2 + (h)) * HTB)
#define PG8_SB(b, h) ((4 + (b) * 2 + (h)) * HTB)
#define PG8_STAGE(bufoff, gbase, voff) do { _Pragma("unroll") for (int _i = 0; _i < 2; ++_i) \
        __builtin_amdgcn_global_load_lds((const unsigned*)((const char*)(gbase) + (voff)[_i]), (LAS unsigned*)(lds + (bufoff) + ldsw + _i * 8192), 16, 0, 0); } while (0)
#define PG8_LDA(dst, b, h) do { _Pragma("unroll") for (int m = 0; m < 4; ++m) _Pragma("unroll") for (int k = 0; k < 2; ++k) dst[m][k] = *(const LAS bf16x8*)(lds + PG8_SA(b, h) + aoff + m * 2048 + k * 1024); } while (0)
#define PG8_LDB(dst, b, h) do { _Pragma("unroll") for (int n = 0; n < 2; ++n) _Pragma("unroll") for (int k = 0; k < 2; ++k) dst[n][k] = *(const LAS bf16x8*)(lds + PG8_SB(b, h) + boff + n * 2048 + k * 1024); } while (0)
#define PG8_MMA(ai, bj, At, Bt) do { __builtin_amdgcn_s_setprio(1); _Pragma("unroll") for (int m = 0; m < 4; ++m) _Pragma("unroll") for (int n = 0; n < 2; ++n) _Pragma("unroll") for (int k = 0; k < 2; ++k) \
        acc[ai][bj][m][n] = __builtin_amdgcn_mfma_f32_16x16x32_bf16(Bt[n][k], At[m][k], acc[ai][bj][m][n], 0, 0, 0); __builtin_amdgcn_s_setprio(0); } while (0)
#define PG8_WAIT_V(n) asm volatile("s_waitcnt vmcnt(" #n ")" ::: "memory")
#define PG8_WAIT_L(n) asm volatile("s_waitcnt lgkmcnt(" #n ")" ::: "memory")
#define PG8_BAR __builtin_amdgcn_s_barrier()
#define PG8_SCHED __builtin_amdgcn_sched_barrier(0)
    Unit cur, nxt; int ui = 0;
    if (!S.next(0, cur)) return;
    f32x4 acc[2][2][4][2];
#pragma unroll
    for (int a = 0; a < 2; ++a)
#pragma unroll
        for (int b = 0; b < 2; ++b)
#pragma unroll
            for (int m = 0; m < 4; ++m)
#pragma unroll
                for (int n = 0; n < 2; ++n) acc[a][b][m][n] = (f32x4){0.f, 0.f, 0.f, 0.f};
    bf16x8 At[4][2], B0[2][2], B1[2][2];
    const char* cA = (const char*)g.A + (size_t)cur.pm * tstep; const char* cB = (const char*)g.Bt + (size_t)cur.pn * tstep;
    PG8_STAGE(PG8_SB(0, 0), cB, voffB); PG8_STAGE(PG8_SA(0, 0), cA, voffA); PG8_STAGE(PG8_SB(0, 1), cB + hstep, voffB); PG8_STAGE(PG8_SA(0, 1), cA + hstep, voffA);
    if (wr == 1) PG8_BAR;
    PG8_WAIT_V(4); PG8_BAR;
    PG8_STAGE(PG8_SB(1, 0), cB + kstep, voffB); PG8_STAGE(PG8_SA(1, 0), cA + kstep, voffA); PG8_STAGE(PG8_SB(1, 1), cB + hstep + kstep, voffB);
    PG8_WAIT_V(6); PG8_BAR;
    for (;;) {
        const bool has_next = S.next(ui + 1, nxt);
        const char* nA = has_next ? (const char*)g.A + (size_t)nxt.pm * tstep : cA; const char* nB = has_next ? (const char*)g.Bt + (size_t)nxt.pn * tstep : cB;
        for (int t = 0; t < nt; t += 2) {
            const bool last = (t == nt - 2);
            const char* a1 = cA + (size_t)(t + 1) * kstep;
            const char* a2 = last ? nA : cA + (size_t)(t + 2) * kstep; const char* b2 = last ? nB : cB + (size_t)(t + 2) * kstep;
            const char* a3 = a2 + kstep; const char* b3 = b2 + kstep;
            PG8_LDB(B0, 0, 0); PG8_SCHED; PG8_LDA(At, 0, 0); PG8_STAGE(PG8_SA(1, 1), a1 + hstep, voffA);
            PG8_WAIT_L(8); PG8_BAR; PG8_WAIT_L(0); PG8_MMA(0, 0, At, B0); PG8_BAR; PG8_SCHED;
            PG8_LDB(B1, 0, 1); PG8_STAGE(PG8_SB(0, 0), b2, voffB);
            PG8_BAR; PG8_WAIT_L(0); PG8_MMA(0, 1, At, B1); PG8_BAR;
            PG8_LDA(At, 0, 1); PG8_STAGE(PG8_SA(0, 0), a2, voffA);
            PG8_BAR; PG8_WAIT_L(0); PG8_MMA(1, 0, At, B0); PG8_BAR; PG8_SCHED;
            PG8_STAGE(PG8_SB(0, 1), b2 + hstep, voffB);
            PG8_WAIT_V(6); PG8_BAR; PG8_MMA(1, 1, At, B1); PG8_BAR;
            PG8_LDB(B0, 1, 0); PG8_SCHED; PG8_LDA(At, 1, 0); PG8_STAGE(PG8_SA(0, 1), a2 + hstep, voffA);
            PG8_WAIT_L(8); PG8_BAR; PG8_WAIT_L(0); PG8_MMA(0, 0, At, B0); PG8_BAR; PG8_SCHED;
            PG8_LDB(B1, 1, 1); PG8_STAGE(PG8_SB(1, 0), b3, voffB);
            PG8_BAR; PG8_WAIT_L(0); PG8_MMA(0, 1, At, B1); PG8_BAR;
            PG8_LDA(At, 1, 1); PG8_STAGE(PG8_SA(1, 0), a3, voffA);
            PG8_BAR; PG8_WAIT_L(0); PG8_MMA(1, 0, At, B0); PG8_BAR; PG8_SCHED;
            PG8_STAGE(PG8_SB(1, 1), b3 + hstep, voffB);
            PG8_WAIT_V(6); PG8_BAR; PG8_MMA(1, 1, At, B1); PG8_BAR;
        }
        if constexpr (Epi::HAS_PRE) { E.pre(lds, cur, ui); E.run(lds, ui, acc, cur, wr, wc, fr, fq); }
        else E(acc, cur, wr, wc, fr, fq);
        if (!has_next) break;
#pragma unroll
        for (int a = 0; a < 2; ++a)
#pragma unroll
            for (int b = 0; b < 2; ++b)
#pragma unroll
                for (int m = 0; m < 4; ++m)
#pragma unroll
                    for (int n = 0; n < 2; ++n) acc[a][b][m][n] = (f32x4){0.f, 0.f, 0.f, 0.f};
        cur = nxt; cA = nA; cB = nB; ++ui;
    }
    PG8_WAIT_V(0);
    if (wr == 0) PG8_BAR;
    PG8_BAR;
#undef PG8_SA
#undef PG8_SB
#undef PG8_STAGE
#undef PG8_LDA
#undef PG8_LDB
#undef PG8_MMA
#undef PG8_WAIT_V
#undef PG8_WAIT_L
#undef PG8_BAR
#undef PG8_SCHED
}
}

#define XB_TMO      128
#define XB_XCNT(j)  (256  + 64 * (j))
#define XB_XSUB(j)  (1280 + 64 * (j))
#define XB_XGEN(j)  (2304 + 64 * (j))
#define XB_TOP      3328
#define XB_TOPGEN   3392
#define XCD_BAR_WORDS 3456
#define XB_SPIN_CAP (1u << 22)
__device__ __forceinline__ unsigned xb_ld(unsigned* p)              { return __hip_atomic_load(p, __ATOMIC_RELAXED, __HIP_MEMORY_SCOPE_AGENT); }
__device__ __forceinline__ unsigned xb_add(unsigned* p, unsigned v) { return __hip_atomic_fetch_add(p, v, __ATOMIC_RELAXED, __HIP_MEMORY_SCOPE_AGENT); }
__device__ __forceinline__ unsigned xb_xcc_id() { return (unsigned)__builtin_amdgcn_s_getreg((3 << 11) | 20) & 0xFu; }
#define XB_SPIN(cond, bar) do { unsigned _sp = 0; while (cond) { __builtin_amdgcn_s_sleep(1); \
    if ((++_sp & 255u) == 0u) { if (xb_ld(&(bar)[XB_TMO])) break; if (_sp > XB_SPIN_CAP) { atomicAdd(&(bar)[XB_TMO], 1u); break; } } } } while (0)
struct XcdBarrier { unsigned* bar; unsigned x; volatile LAS unsigned* st; };
__device__ __forceinline__ XcdBarrier xcd_barrier_post(unsigned* bar, volatile LAS unsigned* st) {
    XcdBarrier b; b.bar = bar; b.x = xb_xcc_id(); b.st = st;
    if (threadIdx.x == 0) (void)xb_add(&bar[XB_XCNT(b.x)], 1u);
    return b;
}
__device__ __forceinline__ void xcd_barrier_complete(unsigned* bar, unsigned x, unsigned& nloc, unsigned& nx) {
    const unsigned G = gridDim.x * gridDim.y * gridDim.z;
    unsigned sum, cnt, mine, sp = 0u;
    for (;;) {
        sum = 0u; cnt = 0u; mine = 0u;
#pragma unroll
        for (unsigned j = 0; j < 16; ++j) { const unsigned c = xb_ld(&bar[XB_XCNT(j)]); sum += c; cnt += (c > 0u) ? 1u : 0u; mine = (j == x) ? c : mine; }
        if (sum == G) break;
        __builtin_amdgcn_s_sleep(1);
        if ((++sp & 255u) == 0u) { if (xb_ld(&bar[XB_TMO])) break; if (sp > XB_SPIN_CAP) { atomicAdd(&bar[XB_TMO], 1u); break; } }
    }
    nloc = mine > 0u ? mine : 1u; nx = cnt > 0u ? cnt : 1u;
}
__device__ __forceinline__ void xcd_barrier(const XcdBarrier& b) {
    asm volatile("s_waitcnt vmcnt(0)" ::: "memory");
    __syncthreads();
    if (threadIdx.x == 0) {
        unsigned* bar = b.bar;
        __builtin_amdgcn_s_waitcnt(0);
        unsigned nloc = b.st[0], nx = b.st[1];
        if (nloc == 0u) { xcd_barrier_complete(bar, b.x, nloc, nx); b.st[0] = nloc; b.st[1] = nx; }
        const unsigned old = xb_add(&bar[XB_XSUB(b.x)], 1u);
        const unsigned gen = old / nloc;
        if (old + 1u == (gen + 1u) * nloc) {
            __builtin_amdgcn_fence(__ATOMIC_RELEASE, "agent");
            asm volatile("s_waitcnt vmcnt(0)" ::: "memory");
            const unsigned og = xb_add(&bar[XB_TOP], 1u);
            const unsigned tg = og / nx;
            if (og + 1u == (tg + 1u) * nx) xb_add(&bar[XB_TOPGEN], 1u);
            else XB_SPIN(xb_ld(&bar[XB_TOPGEN]) == tg, bar);
            __builtin_amdgcn_fence(__ATOMIC_ACQUIRE, "agent");
            xb_add(&bar[XB_XGEN(b.x)], 1u);
            asm volatile("s_waitcnt vmcnt(0)" ::: "memory");
        } else {
            XB_SPIN(xb_ld(&bar[XB_XGEN(b.x)]) == gen, bar);
            __builtin_amdgcn_fence(__ATOMIC_ACQUIRE, "agent");
            asm volatile("s_waitcnt vmcnt(0)" ::: "memory");
        }
    }
    __syncthreads();
}

__device__ __forceinline__ void transpose_item(const float* __restrict__ W, int N, bf16_t* __restrict__ WT, int ldk, int row_off, LAS float* scr, int item, int lane) {
    const int nblk = N / 32, kb = item / nblk, nb = item % nblk, k0 = 64 * kb, n0 = 32 * nb;
    {
        f32x4 tv[8];
#pragma unroll
        for (int i = 0; i < 8; ++i) tv[i] = __builtin_nontemporal_load((const f32x4*)(W + (size_t)(k0 + 8 * i + (lane >> 3)) * N + n0 + 4 * (lane & 7)));
#pragma unroll
        for (int i = 0; i < 8; ++i) { LAS float* d = scr + (8 * i + (lane >> 3)) * 33 + 4 * (lane & 7); d[0] = tv[i][0]; d[1] = tv[i][1]; d[2] = tv[i][2]; d[3] = tv[i][3]; }
    }
    asm volatile("s_waitcnt lgkmcnt(0)" ::: "memory");
    const int c = lane & 7;
#pragma unroll
    for (int j = 0; j < 4; ++j) { const int n = (lane >> 3) + 8 * j; const LAS float* s = scr + (8 * c) * 33 + n;
        u32x4 o; o.x = cvt_pk_bf16(s[0 * 33], s[1 * 33]); o.y = cvt_pk_bf16(s[2 * 33], s[3 * 33]); o.z = cvt_pk_bf16(s[4 * 33], s[5 * 33]); o.w = cvt_pk_bf16(s[6 * 33], s[7 * 33]);
        *(u32x4*)(WT + (size_t)(row_off + n0 + n) * ldk + k0 + 8 * c) = o; }
    asm volatile("s_waitcnt lgkmcnt(0)" ::: "memory");
}
__device__ __forceinline__ void transpose_item_ln(const float* __restrict__ W, int N, bf16_t* __restrict__ WT, int ldk, const float* __restrict__ gk, const float* __restrict__ bk,
                                                  float* __restrict__ pcs, float* __restrict__ pbw, LAS float* scr, int item, int lane) {
    const int nblk = N / 32, kb = item / nblk, nb = item % nblk, k0 = 64 * kb, n0 = 32 * nb;
    {
        f32x4 tv[8];
#pragma unroll
        for (int i = 0; i < 8; ++i) tv[i] = __builtin_nontemporal_load((const f32x4*)(W + (size_t)(k0 + 8 * i + (lane >> 3)) * N + n0 + 4 * (lane & 7)));
#pragma unroll
        for (int i = 0; i < 8; ++i) { LAS float* d = scr + (8 * i + (lane >> 3)) * 33 + 4 * (lane & 7); d[0] = tv[i][0]; d[1] = tv[i][1]; d[2] = tv[i][2]; d[3] = tv[i][3]; }
    }
    asm volatile("s_waitcnt lgkmcnt(0)" ::: "memory");
    const int c = lane & 7;
    float gv[8], bv[8];
#pragma unroll
    for (int i = 0; i < 8; ++i) { gv[i] = gk[k0 + 8 * c + i]; bv[i] = bk[k0 + 8 * c + i]; }
#pragma unroll
    for (int j = 0; j < 4; ++j) { const int n = (lane >> 3) + 8 * j; const LAS float* s = scr + (8 * c) * 33 + n;
        float w[8]; float sb = 0.f;
#pragma unroll
        for (int i = 0; i < 8; ++i) { const float x = s[i * 33]; sb = fmaf(bv[i], x, sb); w[i] = x * gv[i]; }
        u32x4 o; o.x = cvt_pk_bf16(w[0], w[1]); o.y = cvt_pk_bf16(w[2], w[3]); o.z = cvt_pk_bf16(w[4], w[5]); o.w = cvt_pk_bf16(w[6], w[7]);
        *(u32x4*)(WT + (size_t)(n0 + n) * ldk + k0 + 8 * c) = o;
        float sc = ((__uint_as_float(o.x << 16) + __uint_as_float(o.x & 0xffff0000u)) + (__uint_as_float(o.y << 16) + __uint_as_float(o.y & 0xffff0000u)))
                 + ((__uint_as_float(o.z << 16) + __uint_as_float(o.z & 0xffff0000u)) + (__uint_as_float(o.w << 16) + __uint_as_float(o.w & 0xffff0000u)));
        sc += __shfl_xor(sc, 1); sc += __shfl_xor(sc, 2); sc += __shfl_xor(sc, 4);
        sb += __shfl_xor(sb, 1); sb += __shfl_xor(sb, 2); sb += __shfl_xor(sb, 4);
        if (c == 0) { pcs[(size_t)kb * N + n0 + n] = sc; pbw[(size_t)kb * N + n0 + n] = sb; } }
    asm volatile("s_waitcnt lgkmcnt(0)" ::: "memory");
}

struct Params {
    const float *x, *w_in, *conv_w, *a_log, *dt_bias, *dn_norm_w, *attn_sink, *rel_bias, *w_out, *ln1_g, *ln1_b, *peer_wq, *peer_keys, *peer_u, *peer_v, *ln2_g, *ln2_b;
    float* out;
    bf16_t *R, *WOUTT, *WQT;
    bf16_t *AQ, *AK, *AVT, *DQ, *DK, *DV, *DZ; float* BG;
    bf16_t *MIX, *HB, *QP;
    float *PART, *PCS, *PBW, *CS, *BW, *GATE, *US, *VS;
    bf16_t* PREB;
    unsigned char *U8, *V8;
    unsigned* BAR;
    unsigned* FLAG;
    bf16_t *OF, *OB;
    unsigned char *DNS, *DND;
    int* EIDX;
};

__device__ __forceinline__ void phase_prep(const Params& p, LAS unsigned char* lds) {
    int tid_ = threadIdx.x; asm volatile("" : "+v"(tid_) :: "memory");
    const int tid = tid_, wave = tid >> 6, lane = tid & 63, G = gridDim.x;
    {
        const size_t n8 = (size_t)T * D / 8, stride = (size_t)G * NTHREADS;
        for (size_t i = (size_t)blockIdx.x * NTHREADS + tid; i < n8; i += 4 * stride) {
            f32x4 a[4], b[4];
#pragma unroll
            for (int u = 0; u < 4; ++u) { const size_t q = i + u * stride < n8 ? i + u * stride : i; a[u] = __builtin_nontemporal_load((const f32x4*)(p.x + q * 8)); b[u] = __builtin_nontemporal_load((const f32x4*)(p.x + q * 8 + 4)); }
#pragma unroll
            for (int u = 0; u < 4; ++u) {
                u32x4 o; o.x = cvt_pk_bf16(a[u][0], a[u][1]); o.y = cvt_pk_bf16(a[u][2], a[u][3]); o.z = cvt_pk_bf16(b[u][0], b[u][1]); o.w = cvt_pk_bf16(b[u][2], b[u][3]);
                if (i + u * stride < n8) *(u32x4*)(p.R + (i + u * stride) * 8) = o;
            }
        }
    }
    {
        const size_t n16 = (size_t)(5888 - INW) * D * 2 / 16;
        u32x4* z = (u32x4*)(p.R + (size_t)(T + INW) * D);
        for (size_t i = (size_t)blockIdx.x * NTHREADS + tid; i < n16; i += (size_t)G * NTHREADS) z[i] = (u32x4){0u, 0u, 0u, 0u};
    }
    LAS float* scr = (LAS float*)(lds + wave * 8704);
    const int gw = blockIdx.x * 8 + wave, NGW = G * 8;
    constexpr int I_IN = (D / 64) * (INW / 32);
    for (int it = gw; it < I_IN; it += NGW) transpose_item(p.w_in, INW, p.R, D, T, scr, it, lane);
}
__device__ __forceinline__ void phase_prep_late(const Params& p, LAS unsigned char* lds, int bidx, int nblk) {
    int tid_ = threadIdx.x; asm volatile("" : "+v"(tid_) :: "memory");
    const int wave = tid_ >> 6, lane = tid_ & 63;
    LAS float* scr = (LAS float*)(lds + wave * 8704);
    constexpr int I_SQ = (D / 64) * (D / 32);
    for (int it = bidx * 8 + wave; it < 2 * I_SQ; it += nblk * 8) {
        if (it < I_SQ) transpose_item(p.w_out, D, p.WOUTT, D, 0, scr, it, lane);
        else transpose_item_ln(p.peer_wq, D, p.WQT, D, p.ln1_g, p.ln1_b, p.PCS, p.PBW, scr, it - I_SQ, lane);
    }
}

__device__ __forceinline__ void ln_body(int vb, int tid, char* sm, const float* __restrict__ X, const float* __restrict__ g, const float* __restrict__ bta, float* __restrict__ Y, bf16_t* __restrict__ Yb) {
    float* red = (float*)sm;
    const int t = vb;
    __syncthreads();
    const float4* xr = (const float4*)(X + (size_t)t * 2048);
    const float4 a = xr[tid], c = xr[tid + 256];
    float s = (a.x + a.y) + (a.z + a.w) + (c.x + c.y) + (c.z + c.w);
    s = wave_sum(s);
    if ((tid & 63) == 0) red[tid >> 6] = s;
    __syncthreads();
    const float mean = (red[0] + red[1] + red[2] + red[3]) * (1.0f / 2048.0f);
    __syncthreads();
    const float d0 = a.x - mean, d1 = a.y - mean, d2 = a.z - mean, d3 = a.w - mean, d4 = c.x - mean, d5 = c.y - mean, d6 = c.z - mean, d7 = c.w - mean;
    float q = d0 * d0 + d1 * d1 + d2 * d2 + d3 * d3 + d4 * d4 + d5 * d5 + d6 * d6 + d7 * d7;
    q = wave_sum(q);
    if ((tid & 63) == 0) red[tid >> 6] = q;
    __syncthreads();
    const float rstd = 1.0f / sqrtf((red[0] + red[1] + red[2] + red[3]) * (1.0f / 2048.0f) + LN_EPS);
    const float4 g0 = ((const float4*)g)[tid], g1 = ((const float4*)g)[tid + 256], b0 = ((const float4*)bta)[tid], b1 = ((const float4*)bta)[tid + 256];
    float4 o0, o1;
    o0.x = d0 * rstd * g0.x + b0.x; o0.y = d1 * rstd * g0.y + b0.y; o0.z = d2 * rstd * g0.z + b0.z; o0.w = d3 * rstd * g0.w + b0.w;
    o1.x = d4 * rstd * g1.x + b1.x; o1.y = d5 * rstd * g1.y + b1.y; o1.z = d6 * rstd * g1.z + b1.z; o1.w = d7 * rstd * g1.w + b1.w;
    float4* yr = (float4*)(Y + (size_t)t * 2048);
    yr[tid] = o0; yr[tid + 256] = o1;
    u32x2 w0, w1; w0.x = cvt_pk_bf16(o0.x, o0.y); w0.y = cvt_pk_bf16(o0.z, o0.w); w1.x = cvt_pk_bf16(o1.x, o1.y); w1.y = cvt_pk_bf16(o1.z, o1.w);
    u32x2* ybr = (u32x2*)(Yb + (size_t)t * 2048);
    ybr[tid] = w0; ybr[tid + 256] = w1;
}

__device__ __forceinline__ void wave_argmax(float& v, int& i) {
#pragma unroll
    for (int o = 1; o < 64; o <<= 1) {
        const float ov = __shfl_xor(v, o); const int oi = __shfl_xor(i, o);
        if (ov > v || (ov == v && oi < i)) { v = ov; i = oi; }
    }
}
template <class TQ>
__device__ __forceinline__ void select_body(int vb, int tid, char* sm, const TQ* __restrict__ Q, const float* __restrict__ keys, int* __restrict__ eidx, float* __restrict__ gate) {
    float (*qs)[256] = (float (*)[256])sm;
    float (*svs)[2][16] = (float (*)[2][16])(sm + 4096);
    int (*sis)[2][16] = (int (*)[2][16])(sm + 4096 + 512);
    const int wave = tid >> 6, lane = tid & 63;
    const int item = vb * 4 + wave, hd = item & 7, t = item >> 3;
    __syncthreads();
    const TQ* qrow = Q + (size_t)t * 2048 + hd * 256;
#pragma unroll
    for (int j = 0; j < 4; ++j) qs[wave][lane + 64 * j] = ldf(qrow + lane + 64 * j);
    __syncthreads();
    float sc[2][2];
#pragma unroll
    for (int pp = 0; pp < 2; ++pp)
#pragma unroll
        for (int kk = 0; kk < 2; ++kk) {
            const float4* kr = (const float4*)(keys + ((size_t)pp * 128 + lane + 64 * kk) * 128);
            float d = 0.f;
#pragma unroll 2
            for (int c = 0; c < 32; ++c) { const float4 kv = kr[c]; const float4 qv = *(const float4*)&qs[wave][pp * 128 + c * 4]; d += qv.x * kv.x + qv.y * kv.y + qv.z * kv.z + qv.w * kv.w; }
            sc[pp][kk] = d;
        }
#pragma unroll
    for (int pp = 0; pp < 2; ++pp) {
        for (int r = 0; r < 16; ++r) {
            float v; int i;
            if (sc[pp][0] >= sc[pp][1]) { v = sc[pp][0]; i = lane; } else { v = sc[pp][1]; i = lane + 64; }
            wave_argmax(v, i);
            if (lane == 0) { svs[wave][pp][r] = v; sis[wave][pp][r] = i; }
            if (i == lane) sc[pp][0] = -INFINITY;
            if (i == lane + 64) sc[pp][1] = -INFINITY;
        }
    }
    __syncthreads();
    float cs[4];
#pragma unroll
    for (int j = 0; j < 4; ++j) { const int c = lane + 64 * j; cs[j] = svs[wave][0][c >> 4] + svs[wave][1][c & 15]; }
    float tops = 0.f; int topc = 0;
    for (int r = 0; r < 16; ++r) {
        float v = cs[0]; int i = lane;
#pragma unroll
        for (int j = 1; j < 4; ++j) if (cs[j] > v) { v = cs[j]; i = lane + 64 * j; }
        wave_argmax(v, i);
        if (lane == r) { tops = v; topc = i; }
#pragma unroll
        for (int j = 0; j < 4; ++j) if (i == lane + 64 * j) cs[j] = -INFINITY;
    }
    float m = (lane < 16) ? tops : -INFINITY;
    m = wave_max(m);
    const float e = (lane < 16) ? expf(tops - m) : 0.f;
    const float den = wave_sum(e);
    if (lane < 16) {
        const int ex = sis[wave][0][topc >> 4] * 128 + sis[wave][1][topc & 15];
        eidx[(size_t)t * 128 + hd * 16 + lane] = ex;
        gate[(size_t)t * 128 + hd * 16 + lane] = e / den;
    }
}

__device__ __forceinline__ void gather_body(int vb, int tid, const float* __restrict__ H, const int* __restrict__ eidx, const float* __restrict__ gate, const float* __restrict__ U, const float* __restrict__ V,
                                            const float* __restrict__ g2, const float* __restrict__ b2, float* __restrict__ out) {
    const int wave = tid >> 6, lane = tid & 63;
    const int t = vb * 4 + wave;
    const float4* hr = (const float4*)(H + (size_t)t * 2048);
    float4 hv[8], acc[8];
#pragma unroll
    for (int j = 0; j < 8; ++j) { hv[j] = hr[lane + 64 * j]; acc[j] = make_float4(0.f, 0.f, 0.f, 0.f); }
    for (int pp = 0; pp < 128; ++pp) {
        const int e = eidx[(size_t)t * 128 + pp];
        const float gt = gate[(size_t)t * 128 + pp];
        const float4* ur = (const float4*)(U + (size_t)e * 2048);
        float d = 0.f;
#pragma unroll
        for (int j = 0; j < 8; ++j) { const float4 u = ur[lane + 64 * j]; d += u.x * hv[j].x + u.y * hv[j].y + u.z * hv[j].z + u.w * hv[j].w; }
        d = wave_sum(d);
        const float act = 0.5f * d * (1.0f + erff(d * 0.7071067811865476f));
        const float cf = act * gt;
        const float4* vr = (const float4*)(V + (size_t)e * 2048);
#pragma unroll
        for (int j = 0; j < 8; ++j) { const float4 vv = vr[lane + 64 * j]; acc[j].x += cf * vv.x; acc[j].y += cf * vv.y; acc[j].z += cf * vv.z; acc[j].w += cf * vv.w; }
    }
    float s = 0.f;
#pragma unroll
    for (int j = 0; j < 8; ++j) { acc[j].x += ALPHA * hv[j].x; acc[j].y += ALPHA * hv[j].y; acc[j].z += ALPHA * hv[j].z; acc[j].w += ALPHA * hv[j].w; s += (acc[j].x + acc[j].y) + (acc[j].z + acc[j].w); }
    const float mean = wave_sum(s) * (1.0f / 2048.0f);
    float q = 0.f;
#pragma unroll
    for (int j = 0; j < 8; ++j) { acc[j].x -= mean; acc[j].y -= mean; acc[j].z -= mean; acc[j].w -= mean; q += acc[j].x * acc[j].x + acc[j].y * acc[j].y + acc[j].z * acc[j].z + acc[j].w * acc[j].w; }
    const float rstd = 1.0f / sqrtf(wave_sum(q) * (1.0f / 2048.0f) + LN_EPS);
    float4* orow = (float4*)(out + (size_t)t * 2048);
#pragma unroll
    for (int j = 0; j < 8; ++j) {
        const float4 g = ((const float4*)g2)[lane + 64 * j], bb = ((const float4*)b2)[lane + 64 * j];
        float4 o; o.x = acc[j].x * rstd * g.x + bb.x; o.y = acc[j].y * rstd * g.y + bb.y; o.z = acc[j].z * rstd * g.z + bb.z; o.w = acc[j].w * rstd * g.w + bb.w;
        orow[lane + 64 * j] = o;
    }
}

constexpr int DNS_QN = 0, DNS_KNT = 16384, DNS_SIZE = 32768;
constexpr int DND_WN = 0, DND_UT = 16384, DND_AM = 32768, DND_EG = 40960, DND_EGL = 41216, DND_GL = 41472, DND_SIZE = 41984;

__device__ __forceinline__ f32x4 mfma16(bf16x8 a, bf16x8 b, f32x4 c) { return __builtin_amdgcn_mfma_f32_16x16x32_bf16(a, b, c, 0, 0, 0); }
template <int CTRL> __device__ __forceinline__ float dpp_mov(float v) { return __int_as_float(__builtin_amdgcn_update_dpp(0, __float_as_int(v), CTRL, 0xF, 0xF, true)); }
__device__ __forceinline__ float quad_sum(float v) { v += dpp_mov<0xB1>(v); v += dpp_mov<0x4E>(v); return v; }
__device__ __forceinline__ float row16_sum(float v) { v = quad_sum(v); v += dpp_mov<0x141>(v); v += dpp_mov<0x140>(v); return v; }

template <int MODE> __device__ __forceinline__ void gst64(void* ptr, u32x2 v) {
    if (MODE) __hip_atomic_store((unsigned long long*)ptr, ((unsigned long long)v.y << 32) | (unsigned long long)v.x, __ATOMIC_RELAXED, __HIP_MEMORY_SCOPE_AGENT);
    else *(u32x2*)ptr = v;
}
template <int MODE> __device__ __forceinline__ void gst128(void* ptr, u32x4 v) {
    if (MODE) { gst64<1>(ptr, (u32x2){v.x, v.y}); gst64<1>((unsigned char*)ptr + 8, (u32x2){v.z, v.w}); }
    else *(u32x4*)ptr = v;
}
template <int MODE> __device__ __forceinline__ void gst32(float* ptr, float v) {
    if (MODE) __hip_atomic_store(ptr, v, __ATOMIC_RELAXED, __HIP_MEMORY_SCOPE_AGENT);
    else *ptr = v;
}
constexpr int DN_LEVEL0 = 20;
template <int MODE>
__device__ __forceinline__ void phase_dnprep(const Params& p, LAS unsigned char* lds) {
    constexpr int L_QN = 0, L_KN = 17408;
    constexpr int L_KT = 34816, L_VT = L_KT + 18432;
    constexpr int L_T = L_VT + 18432;
    constexpr int L_CW = L_T + 4 * 9216;
    constexpr int L_SM = L_CW + 7680;
    int tid_ = threadIdx.x; asm volatile("" : "+v"(tid_) :: "memory");
    LAS float* convw = (LAS float*)(lds + L_CW);
    LAS float* betas = (LAS float*)(lds + L_SM);
    LAS float* Gs = betas + 128;
    int prev_it = -1;
#pragma unroll 1
    for (int ii = 0; ii < (MODE ? 4 : 5); ++ii) {
        const int nn = MODE == 0 ? (int)blockIdx.x + 256 * ii : 64 * DN_LEVEL0 + 192 * ii + ((int)blockIdx.x - 64);
        const int it = (nn & 31) * 64 + ((nn & 32) ? 63 - (nn >> 6) : (nn >> 6));
        asm volatile("" : "+v"(tid_) :: "memory");
        const int tid = tid_, wave = tid >> 6, lane = tid & 63, n16 = lane & 15, g = lane >> 4;
        const int c = it & 63, bh = it >> 6, h = bh & 7, b = bh >> 3;
        const size_t t0 = (size_t)b * S + c * 64;
        unsigned char* srec = p.DNS + (size_t)it * DNS_SIZE;
        unsigned char* drec0 = p.DND + (size_t)it * 2 * DND_SIZE;
        const int r32 = tid >> 4, cg = tid & 15;
        u32x4 raw0[3][5], raw1[3][5];
#define DN_LOAD_RAW(RAW, PASS, tensor) { \
            const bf16_t* base = ((tensor) == 0 ? p.DQ : ((tensor) == 1 ? p.DK : p.DV)) + (size_t)b * S * 1024 + h * 128 + 8 * cg; \
            _Pragma("unroll") for (int j = 0; j < 5; ++j) { const int sj = c * 64 + (PASS) * 32 + r32 + j - 2; const bool ok = (sj >= 0 && sj < S); \
                const u32x4 ld = *(const u32x4*)(base + (size_t)(ok ? sj : 0) * 1024); RAW[tensor][j] = ok ? ld : (u32x4){0u, 0u, 0u, 0u}; } }
        DN_LOAD_RAW(raw0, 0, 0) DN_LOAD_RAW(raw0, 0, 1) DN_LOAD_RAW(raw0, 0, 2)
        for (int i = tid; i < 1920; i += NTHREADS) { const int tensor = i / 640, rem = i % 640, j = rem >> 7, ch = rem & 127; convw[i] = p.conv_w[j * 3072 + tensor * 1024 + h * 128 + ch]; }
        if (tid < 128) {
            const int dir = tid >> 6, r = tid & 63;
            const float braw = p.BG[(t0 + r) * 32 + dir * 8 + h], araw = p.BG[(t0 + r) * 32 + 16 + dir * 8 + h];
            const float beta = sigmoid_f(braw);
            const float gg = -expf(p.a_log[dir * 8 + h]) * softplus_f(araw + p.dt_bias[dir * 8 + h]);
            float Gc = gg;
#pragma unroll
            for (int o = 1; o < 64; o <<= 1) { const float up = __shfl_up(Gc, o), dn = __shfl_down(Gc, o); if (dir == 0) { if (r >= o) Gc += up; } else { if (r + o < 64) Gc += dn; } }
            const float Glast = __shfl(Gc, dir ? 0 : 63);
            betas[dir * 64 + r] = beta; Gs[dir * 64 + r] = Gc * 1.4426950408889634f;
            float* eg = (float*)(drec0 + (size_t)dir * DND_SIZE + DND_EG);
            gst32<MODE>(eg + r, expf(Gc)); gst32<MODE>(eg + 64 + r, expf(Glast - Gc));
            if (r == 0) gst32<MODE>(eg + 128, expf(Glast));
        }
        if (MODE) asm volatile("s_waitcnt vmcnt(0)" ::: "memory");
        __syncthreads();
        if (MODE && threadIdx.x == 0 && prev_it >= 0) (void)xb_add(&p.FLAG[prev_it], 1u);
#pragma unroll
        for (int pass = 0; pass < 2; ++pass) {
            const int r = pass * 32 + r32;
            const int tro = (((r >> 3) ^ (cg & 7)) << 4) + (r & 7) * 2;
#pragma unroll
            for (int tensor = 0; tensor < 3; ++tensor) {
                asm volatile("" ::: "memory");
                if (pass == 0) DN_LOAD_RAW(raw1, 1, tensor)
                asm volatile("" ::: "memory");
                float a[8];
#pragma unroll
                for (int i = 0; i < 8; ++i) a[i] = 0.f;
#pragma unroll
                for (int j = 0; j < 5; ++j) {
                    const u32x4 rw = pass ? raw1[tensor][j] : raw0[tensor][j];
                    const f32x4 w0 = *(const LAS f32x4*)(convw + tensor * 640 + j * 128 + 8 * cg), w1 = *(const LAS f32x4*)(convw + tensor * 640 + j * 128 + 8 * cg + 4);
                    a[0] = fmaf(w0[0], __uint_as_float(rw.x << 16), a[0]); a[1] = fmaf(w0[1], __uint_as_float(rw.x & 0xffff0000u), a[1]);
                    a[2] = fmaf(w0[2], __uint_as_float(rw.y << 16), a[2]); a[3] = fmaf(w0[3], __uint_as_float(rw.y & 0xffff0000u), a[3]);
                    a[4] = fmaf(w1[0], __uint_as_float(rw.z << 16), a[4]); a[5] = fmaf(w1[1], __uint_as_float(rw.z & 0xffff0000u), a[5]);
                    a[6] = fmaf(w1[2], __uint_as_float(rw.w << 16), a[6]); a[7] = fmaf(w1[3], __uint_as_float(rw.w & 0xffff0000u), a[7]);
                }
                float y[8]; float ss = 0.f;
#pragma unroll
                for (int i = 0; i < 8; ++i) { y[i] = silu_f(a[i]); ss = fmaf(y[i], y[i], ss); }
                if (tensor < 2) {
                    ss = row16_sum(ss);
                    const float rn = __builtin_amdgcn_rsqf(ss + RMS_EPS) * (tensor == 0 ? 0.08838834764831845f : 1.0f);
#pragma unroll
                    for (int i = 0; i < 8; ++i) y[i] *= rn;
                    u32x4 pv; pv.x = cvt_pk_bf16(y[0], y[1]); pv.y = cvt_pk_bf16(y[2], y[3]); pv.z = cvt_pk_bf16(y[4], y[5]); pv.w = cvt_pk_bf16(y[6], y[7]);
                    *(LAS u32x4*)(lds + (tensor == 0 ? L_QN : L_KN) + r * 272 + cg * 16) = pv;
                    if (tensor == 0) gst128<MODE>(srec + DNS_QN + r * 256 + cg * 16, pv);
                }
                if (tensor >= 1) {
#pragma unroll
                    for (int i = 0; i < 8; ++i) *(LAS bf16_t*)(lds + (tensor == 1 ? L_KT : L_VT) + (8 * cg + i) * 144 + tro) = f2bf(y[i]);
                }
            }
        }
#undef DN_LOAD_RAW
        __syncthreads();
        {
#pragma unroll
            for (int i = 0; i < 2; ++i) { const int q = tid + NTHREADS * i, row = q >> 3, c8 = q & 7;
                gst128<MODE>(srec + DNS_KNT + row * 128 + c8 * 16, *(const LAS u32x4*)(lds + L_KT + row * 144 + ((c8 ^ ((row >> 3) & 7)) << 4))); }
        }
        f32x4 kk2[2], qk2[2];
#pragma unroll
        for (int jb = 0; jb < 2; ++jb) {
            const int job = wave * 2 + jb, ta = job >> 2, tb = job & 3;
            f32x4 ak = (f32x4){0.f, 0.f, 0.f, 0.f}, aq = (f32x4){0.f, 0.f, 0.f, 0.f};
#pragma unroll
            for (int ks = 0; ks < 4; ++ks) {
                const bf16x8 ka = *(const LAS bf16x8*)(lds + L_KN + (16 * ta + n16) * 272 + ks * 64 + g * 16);
                const bf16x8 kb = *(const LAS bf16x8*)(lds + L_KN + (16 * tb + n16) * 272 + ks * 64 + g * 16);
                const bf16x8 qb = *(const LAS bf16x8*)(lds + L_QN + (16 * tb + n16) * 272 + ks * 64 + g * 16);
                ak = mfma16(ka, kb, ak);
                aq = mfma16(ka, qb, aq);
            }
            kk2[jb] = ak; qk2[jb] = aq;
        }
        __syncthreads();
#pragma unroll
        for (int jb = 0; jb < 2; ++jb) {
            const int job = wave * 2 + jb, ta = job >> 2, tb = job & 3;
            {
                const int j = 16 * tb + n16;
                const float G0j = Gs[j], G1j = Gs[64 + j];
#pragma unroll
                for (int rr = 0; rr < 4; ++rr) {
                    const int i = 16 * ta + 4 * g + rr;
                    const float kkv = kk2[jb][rr];
                    const float l0 = (j < i) ? betas[i] * kkv * __builtin_amdgcn_exp2f(Gs[i] - G0j) : 0.f;
                    const float l1 = (j > i) ? betas[64 + i] * kkv * __builtin_amdgcn_exp2f(Gs[64 + i] - G1j) : 0.f;
                    *(LAS float*)(lds + L_QN + (i * 64 + (j & 3) * 16 + (j >> 2)) * 4) = l0;
                    const int ir = 63 - i, jr = 63 - j;
                    *(LAS float*)(lds + L_KN + (ir * 64 + (jr & 3) * 16 + (jr >> 2)) * 4) = l1;
                }
            }
            {
                const int i = 16 * tb + n16;
                const float G0i = Gs[i], G1i = Gs[64 + i];
                float a0[4], a1[4];
#pragma unroll
                for (int rr = 0; rr < 4; ++rr) {
                    const int j = 16 * ta + 4 * g + rr;
                    const float qkv = qk2[jb][rr];
                    a0[rr] = (j <= i) ? qkv * __builtin_amdgcn_exp2f(G0i - Gs[j]) : 0.f;
                    a1[rr] = (j >= i) ? qkv * __builtin_amdgcn_exp2f(G1i - Gs[64 + j]) : 0.f;
                }
                u32x2 w0, w1; w0.x = cvt_pk_bf16(a0[0], a0[1]); w0.y = cvt_pk_bf16(a0[2], a0[3]); w1.x = cvt_pk_bf16(a1[0], a1[1]); w1.y = cvt_pk_bf16(a1[2], a1[3]);
                gst64<MODE>(drec0 + DND_AM + (i * 64 + 16 * ta + 4 * g) * 2, w0);
                gst64<MODE>(drec0 + DND_SIZE + DND_AM + (i * 64 + 16 * ta + 4 * g) * 2, w1);
            }
        }
        __syncthreads();
        {
            const int dir = wave >> 2, cb = __builtin_amdgcn_readfirstlane(dir ? 3 - (wave & 3) : (wave & 3)), nblk = 4 - cb, cl = lane >> 2, q = lane & 3;
            const LAS float* Lq = (const LAS float*)(lds + (dir ? L_KN : L_QN)) + q * 16 + (16 * cb) * 64 + 4 * cb;
            float Tq[16];
#pragma unroll
            for (int m = 0; m < 16; ++m) Tq[m] = 0.f;
            f32x4 lv[2][4];
            lv[0][0] = *(const LAS f32x4*)(Lq);
#define S3_STEPS(LO) _Pragma("unroll") for (int i = (LO); i < (LO) + 16; ++i) { \
                const int mi = i >> 2, qi = i & 3; \
                if (i < 63) { _Pragma("unroll") for (int mm = 0; mm <= ((i + 1) >> 4); ++mm) lv[(i + 1) & 1][mm] = *(const LAS f32x4*)(Lq + (i + 1) * 64 + 4 * mm); } \
                float acc0 = 0.f, acc1 = 0.f; \
                _Pragma("unroll") for (int mm = 0; mm <= (mi >> 2); ++mm) { \
                    const f32x4 l4 = lv[i & 1][mm]; \
                    acc0 = fmaf(l4[0], Tq[4 * mm], acc0); acc1 = fmaf(l4[1], Tq[4 * mm + 1], acc1); \
                    acc0 = fmaf(l4[2], Tq[4 * mm + 2], acc0); acc1 = fmaf(l4[3], Tq[4 * mm + 3], acc1); } \
                const float tot = quad_sum(acc0 + acc1); \
                const float val = ((cl == i) ? 1.0f : 0.0f) - tot; \
                Tq[mi] = (q == qi) ? val : Tq[mi]; }
            S3_STEPS(0)
            if (nblk > 1) { S3_STEPS(16)
                if (nblk > 2) { S3_STEPS(32)
                    if (nblk > 3) { S3_STEPS(48) } } }
#undef S3_STEPS
            const int cidx = 16 * cb + cl;
            const int col = dir ? (63 - cidx) : cidx;
            const float bc = betas[dir * 64 + col], bgc = bc * __builtin_amdgcn_exp2f(Gs[dir * 64 + col]);
#pragma unroll
            for (int m = 0; m < 16; ++m) {
                if (m < 4 * nblk) {
                    const int i = 16 * cb + 4 * m + q;
                    const int row = dir ? (63 - i) : i;
                    *(LAS bf16_t*)(lds + L_T + dir * 9216 + row * 144 + col * 2) = f2bf(Tq[m] * bc);
                    *(LAS bf16_t*)(lds + L_T + (2 + dir) * 9216 + row * 144 + col * 2) = f2bf(Tq[m] * bgc);
                } else {
                    const int i = 4 * (m - 4 * nblk) + q;
                    const int row = dir ? (63 - i) : i;
                    *(LAS bf16_t*)(lds + L_T + dir * 9216 + row * 144 + col * 2) = (bf16_t)0;
                    *(LAS bf16_t*)(lds + L_T + (2 + dir) * 9216 + row * 144 + col * 2) = (bf16_t)0;
                }
            }
        }
        __syncthreads();
#pragma unroll 4
        for (int jj = 0; jj < 16; ++jj) {
            const int job = wave * 16 + jj, dir = job >> 6, kind = (job >> 5) & 1, tl = job & 31;
            const LAS unsigned char* Tb = lds + L_T + (2 * kind + dir) * 9216;
            unsigned char* drec = drec0 + (size_t)dir * DND_SIZE;
            f32x4 acc = (f32x4){0.f, 0.f, 0.f, 0.f};
            if (kind == 0) {
                const int itl = tl >> 3, ct = tl & 7, ch = 16 * ct + n16;
                const LAS unsigned char* Vb = lds + L_VT + ch * 144;
#pragma unroll
                for (int ks = 0; ks < 2; ++ks) {
                    const bf16x8 a = *(const LAS bf16x8*)(Tb + (16 * itl + n16) * 144 + ks * 64 + g * 16);
                    const bf16x8 bb = *(const LAS bf16x8*)(Vb + (((4 * ks + g) ^ ((ch >> 3) & 7)) << 4));
                    acc = mfma16(a, bb, acc);
                }
                u32x2 w; w.x = cvt_pk_bf16(acc[0], acc[1]); w.y = cvt_pk_bf16(acc[2], acc[3]);
                gst64<MODE>(drec + DND_UT + (ch * 64 + 16 * itl + 4 * g) * 2, w);
            } else {
                const int dt = tl >> 2, itl = tl & 3, dk = 16 * dt + n16;
                const LAS unsigned char* Kb = lds + L_KT + dk * 144;
#pragma unroll
                for (int ks = 0; ks < 2; ++ks) {
                    const bf16x8 a = *(const LAS bf16x8*)(Kb + (((4 * ks + g) ^ ((dk >> 3) & 7)) << 4));
                    const bf16x8 bb = *(const LAS bf16x8*)(Tb + (16 * itl + n16) * 144 + ks * 64 + g * 16);
                    acc = mfma16(a, bb, acc);
                }
                u32x2 w; w.x = cvt_pk_bf16(-acc[0], -acc[1]); w.y = cvt_pk_bf16(-acc[2], -acc[3]);
                gst64<MODE>(drec + DND_WN + ((16 * itl + n16) * 128 + 16 * dt + 4 * g) * 2, w);
            }
        }
        __syncthreads();
        prev_it = it;
    }
    if (MODE) {
        asm volatile("s_waitcnt vmcnt(0)" ::: "memory");
        __syncthreads();
        if (threadIdx.x == 0 && prev_it >= 0) (void)xb_add(&p.FLAG[prev_it], 1u);
    }
}

__device__ __forceinline__ void phase_dnscan(const Params& p, LAS unsigned char* lds) {
    constexpr int B_WN = 0, B_QN = 16384, B_AM = 32768, B_KNT = 40960, B_EG = 57344, B_SIZE = 57344 + 1024;
    int tid_ = threadIdx.x; asm volatile("" : "+v"(tid_) :: "memory");
    const int tid = tid_, wave = tid >> 6, lane = tid & 63, n16 = lane & 15, g = lane >> 4;
    const int chain = blockIdx.x, dir = chain & 1, h = (chain >> 1) & 7, b = chain >> 4, bh = b * 8 + h;
    const int dv0 = wave * 16;
    bf16_t* O = dir ? p.OB : p.OF;
    int ldst1[7], ldst2[7];
#pragma unroll
    for (int i = 0; i < 7; ++i) {
        const int q = tid + NTHREADS * i;
        if (i < 4) {
            const int qq = q & 1023, row = qq >> 4, k8 = qq & 15, kb = k8 >> 2, c4 = k8 & 3;
            const int off1 = kb * 64 + (c4 & 1) * 32 + (c4 >> 1) * 8, off2 = off1 + 16;
            const int base = (i < 2 ? B_WN : B_QN) + row * 256, sw = (row & 15) << 4;
            ldst1[i] = base + (off1 ^ sw); ldst2[i] = base + (off2 ^ sw);
        } else {
            const int qq = (i == 4) ? (q - 2048) : (q - 2560), row = qq >> 3, c8 = qq & 7, kb = c8 >> 2, c4 = c8 & 3;
            const int off1 = kb * 64 + (c4 & 1) * 32 + (c4 >> 1) * 8, off2 = off1 + 16;
            const int base = (i == 4 ? B_AM : B_KNT) + row * 128, sw = ((row >> 1) & 7) << 4;
            ldst1[i] = base + (off1 ^ sw); ldst2[i] = base + (off2 ^ sw);
        }
    }
    u32x4 st[7]; u32x4 stg = (u32x4){0u, 0u, 0u, 0u}; u32x2 ut[4];
    auto issue_loads = [&](int cidx) {
        const int rec = bh * 64 + cidx;
        const unsigned char* srec = p.DNS + (size_t)rec * DNS_SIZE;
        const unsigned char* drec = p.DND + ((size_t)rec * 2 + dir) * DND_SIZE;
        st[0] = *(const u32x4*)(drec + DND_WN + tid * 16); st[1] = *(const u32x4*)(drec + DND_WN + (tid + 512) * 16);
        st[2] = *(const u32x4*)(srec + DNS_QN + tid * 16); st[3] = *(const u32x4*)(srec + DNS_QN + (tid + 512) * 16);
        st[4] = *(const u32x4*)(drec + DND_AM + tid * 16);
        st[5] = *(const u32x4*)(srec + DNS_KNT + tid * 16); st[6] = *(const u32x4*)(srec + DNS_KNT + (tid + 512) * 16);
        if (tid < 33) stg = *(const u32x4*)(drec + DND_EG + tid * 16);
#pragma unroll
        for (int m = 0; m < 4; ++m) ut[m] = *(const u32x2*)(drec + DND_UT + ((dv0 + n16) * 64 + 16 * m + 4 * g) * 2);
    };
    auto write_stage = [&](int buf) {
        LAS unsigned char* bb = lds + buf * B_SIZE;
#pragma unroll
        for (int i = 0; i < 7; ++i) { *(LAS u32x2*)(bb + ldst1[i]) = (u32x2){st[i].x, st[i].y}; *(LAS u32x2*)(bb + ldst2[i]) = (u32x2){st[i].z, st[i].w}; }
        if (tid < 33) *(LAS u32x4*)(bb + B_EG + tid * 16) = stg;
    };
    f32x4 Sst[8];
#pragma unroll
    for (int mm = 0; mm < 8; ++mm) Sst[mm] = (f32x4){0.f, 0.f, 0.f, 0.f};
    issue_loads(dir ? 63 : 0);
    write_stage(0);
    u32x2 utc[4];
#pragma unroll
    for (int m = 0; m < 4; ++m) utc[m] = ut[m];
    __syncthreads();
    unsigned fl = 1u;
#pragma unroll 1
    for (int k = 0; k < 64; ++k) {
        const int cidx = dir ? (63 - k) : k;
        if (k + 1 < 64) {
            const int cn = dir ? (62 - k) : (k + 1);
            if (fl == 0u) XB_SPIN(xb_ld(&p.FLAG[bh * 64 + cn]) == 0u, p.BAR);
            issue_loads(cn);
        }
        if (k + 2 < 64) { const int c2 = dir ? (61 - k) : (k + 2); fl = ((c2 < 32 ? c2 : 63 - c2) >= DN_LEVEL0) ? xb_ld(&p.FLAG[bh * 64 + c2]) : 1u; }
        const LAS unsigned char* bb = lds + (k & 1) * B_SIZE;
        bf16x8 BS[4];
#pragma unroll
        for (int ks = 0; ks < 4; ++ks) {
            u32x4 w; w.x = cvt_pk_bf16(Sst[2 * ks][0], Sst[2 * ks][1]); w.y = cvt_pk_bf16(Sst[2 * ks][2], Sst[2 * ks][3]);
            w.z = cvt_pk_bf16(Sst[2 * ks + 1][0], Sst[2 * ks + 1][1]); w.w = cvt_pk_bf16(Sst[2 * ks + 1][2], Sst[2 * ks + 1][3]);
            BS[ks] = __builtin_bit_cast(bf16x8, w);
        }
        f32x4 vn[4], oq[4];
        bf16x8 fw[2][4], fq[2][4];
#define SC_LD_WQ(slot, m) { const int rowo_ = (16 * (m) + n16) * 256, sw_ = n16 << 4; \
            _Pragma("unroll") for (int ks = 0; ks < 4; ++ks) { fw[slot][ks] = *(const LAS bf16x8*)(bb + B_WN + rowo_ + ((ks * 64 + g * 16) ^ sw_)); fq[slot][ks] = *(const LAS bf16x8*)(bb + B_QN + rowo_ + ((ks * 64 + g * 16) ^ sw_)); } }
        SC_LD_WQ(0, 0)
#pragma unroll
        for (int m = 0; m < 4; ++m) {
            if (m < 3) SC_LD_WQ((m + 1) & 1, m + 1)
            vn[m] = (f32x4){__uint_as_float(utc[m].x << 16), __uint_as_float(utc[m].x & 0xffff0000u), __uint_as_float(utc[m].y << 16), __uint_as_float(utc[m].y & 0xffff0000u)};
            oq[m] = (f32x4){0.f, 0.f, 0.f, 0.f};
#pragma unroll
            for (int ks = 0; ks < 4; ++ks) { vn[m] = mfma16(fw[m & 1][ks], BS[ks], vn[m]); oq[m] = mfma16(BS[ks], fq[m & 1][ks], oq[m]); }
            oq[m] = oq[m] * *(const LAS float*)(bb + B_EG + (16 * m + n16) * 4);
        }
#undef SC_LD_WQ
        bf16x8 fa[4][2];
#pragma unroll
        for (int m = 0; m < 4; ++m) { const int rowo = (16 * m + n16) * 128, sw = ((n16 >> 1) & 7) << 4;
#pragma unroll
            for (int ks = 0; ks < 2; ++ks) fa[m][ks] = *(const LAS bf16x8*)(bb + B_AM + rowo + ((ks * 64 + g * 16) ^ sw)); }
        bf16x8 BV[2], BVs[2];
#pragma unroll
        for (int ks = 0; ks < 2; ++ks) {
            const f32x4 e0 = *(const LAS f32x4*)(bb + B_EG + 256 + (32 * ks + 4 * g) * 4), e1 = *(const LAS f32x4*)(bb + B_EG + 256 + (32 * ks + 16 + 4 * g) * 4);
            const f32x4 a0 = vn[2 * ks], a1 = vn[2 * ks + 1], s0 = a0 * e0, s1 = a1 * e1;
            u32x4 w; w.x = cvt_pk_bf16(a0[0], a0[1]); w.y = cvt_pk_bf16(a0[2], a0[3]); w.z = cvt_pk_bf16(a1[0], a1[1]); w.w = cvt_pk_bf16(a1[2], a1[3]);
            BV[ks] = __builtin_bit_cast(bf16x8, w);
            u32x4 ws; ws.x = cvt_pk_bf16(s0[0], s0[1]); ws.y = cvt_pk_bf16(s0[2], s0[3]); ws.z = cvt_pk_bf16(s1[0], s1[1]); ws.w = cvt_pk_bf16(s1[2], s1[3]);
            BVs[ks] = __builtin_bit_cast(bf16x8, ws);
        }
        bf16x8 fk[2][4][2];
#define SC_LD_K(slot, half) { _Pragma("unroll") for (int q4 = 0; q4 < 4; ++q4) { const int rowo_ = (16 * (4 * (half) + q4) + n16) * 128, sw_ = ((n16 >> 1) & 7) << 4; \
            _Pragma("unroll") for (int ks = 0; ks < 2; ++ks) fk[slot][q4][ks] = *(const LAS bf16x8*)(bb + B_KNT + rowo_ + ((ks * 64 + g * 16) ^ sw_)); } }
        SC_LD_K(0, 0)
#pragma unroll
        for (int m = 0; m < 4; ++m) {
#pragma unroll
            for (int ks = 0; ks < 2; ++ks) oq[m] = mfma16(BV[ks], fa[m][ks], oq[m]);
            u32x2 w; w.x = cvt_pk_bf16(oq[m][0], oq[m][1]); w.y = cvt_pk_bf16(oq[m][2], oq[m][3]);
            *(u32x2*)(O + ((size_t)b * S + cidx * 64 + 16 * m + n16) * 1024 + h * 128 + dv0 + 4 * g) = w;
        }
        const float gl = *(const LAS float*)(bb + B_EG + 512);
        SC_LD_K(1, 1)
#pragma unroll
        for (int mm = 0; mm < 8; ++mm) {
            Sst[mm] = Sst[mm] * gl;
#pragma unroll
            for (int ks = 0; ks < 2; ++ks) Sst[mm] = mfma16(fk[mm >> 2][mm & 3][ks], BVs[ks], Sst[mm]);
        }
#undef SC_LD_K
        if (k + 1 < 64) {
            write_stage((k + 1) & 1);
#pragma unroll
            for (int m = 0; m < 4; ++m) utc[m] = ut[m];
        }
        __syncthreads();
    }
}

__device__ __forceinline__ void phase_dncombine(const Params& p) {
    int tid_ = threadIdx.x; asm volatile("" : "+v"(tid_) :: "memory");
    const int tid = tid_;
    {
        const int n = blockIdx.x * NTHREADS + tid;
        if (n < D) { float a = 0.f, bsum = 0.f;
#pragma unroll 8
            for (int kb = 0; kb < 32; ++kb) { a += p.PCS[(size_t)kb * D + n]; bsum += p.PBW[(size_t)kb * D + n]; }
            p.CS[n] = a; p.BW[n] = bsum; }
    }
    const int nitem = T * 8;
    for (int base = (blockIdx.x * NTHREADS + tid) >> 4; base < nitem; base += (gridDim.x * NTHREADS) >> 4) {
        const int l16 = tid & 15, h = base & 7, t = base >> 3;
        const size_t idx = (size_t)t * 1024 + h * 128 + 8 * l16;
        const u32x4 a = *(const u32x4*)(p.OF + idx), bq = *(const u32x4*)(p.OB + idx), z = *(const u32x4*)(p.DZ + idx);
        float o[8];
        o[0] = __uint_as_float(a.x << 16) + __uint_as_float(bq.x << 16); o[1] = __uint_as_float(a.x & 0xffff0000u) + __uint_as_float(bq.x & 0xffff0000u);
        o[2] = __uint_as_float(a.y << 16) + __uint_as_float(bq.y << 16); o[3] = __uint_as_float(a.y & 0xffff0000u) + __uint_as_float(bq.y & 0xffff0000u);
        o[4] = __uint_as_float(a.z << 16) + __uint_as_float(bq.z << 16); o[5] = __uint_as_float(a.z & 0xffff0000u) + __uint_as_float(bq.z & 0xffff0000u);
        o[6] = __uint_as_float(a.w << 16) + __uint_as_float(bq.w << 16); o[7] = __uint_as_float(a.w & 0xffff0000u) + __uint_as_float(bq.w & 0xffff0000u);
        float zz[8];
        zz[0] = __uint_as_float(z.x << 16); zz[1] = __uint_as_float(z.x & 0xffff0000u); zz[2] = __uint_as_float(z.y << 16); zz[3] = __uint_as_float(z.y & 0xffff0000u);
        zz[4] = __uint_as_float(z.z << 16); zz[5] = __uint_as_float(z.z & 0xffff0000u); zz[6] = __uint_as_float(z.w << 16); zz[7] = __uint_as_float(z.w & 0xffff0000u);
        float ss = 0.f;
#pragma unroll
        for (int i = 0; i < 8; ++i) ss = fmaf(o[i], o[i], ss);
        ss += __shfl_xor(ss, 1); ss += __shfl_xor(ss, 2); ss += __shfl_xor(ss, 4); ss += __shfl_xor(ss, 8);
        const float rn = __builtin_amdgcn_rsqf(ss * (1.0f / 128.0f) + RMS_EPS);
        const f32x4 nw0 = *(const f32x4*)(p.dn_norm_w + 8 * l16), nw1 = *(const f32x4*)(p.dn_norm_w + 8 * l16 + 4);
        float r[8];
#pragma unroll
        for (int i = 0; i < 8; ++i) r[i] = o[i] * rn * (i < 4 ? nw0[i] : nw1[i - 4]) * silu_f(zz[i]);
        u32x4 w; w.x = cvt_pk_bf16(r[0], r[1]); w.y = cvt_pk_bf16(r[2], r[3]); w.z = cvt_pk_bf16(r[4], r[5]); w.w = cvt_pk_bf16(r[6], r[7]);
        *(u32x4*)(p.MIX + (size_t)t * 2048 + 1024 + h * 128 + 8 * l16) = w;
    }
}

typedef float f32x16 __attribute__((ext_vector_type(16)));
__device__ __forceinline__ f32x16 mfma32(bf16x8 a, bf16x8 b, f32x16 c) { return __builtin_amdgcn_mfma_f32_32x32x16_bf16(a, b, c, 0, 0, 0); }
__device__ __forceinline__ void phase_attn(const Params& p, LAS unsigned char* lds, int bidx, int nblk) {
    constexpr float LOG2E = 1.4426950408889634f, C1 = 0.08838834764831845f * 1.4426950408889634f;
    constexpr int L_BT = 0;
    constexpr int L_K = 8448;
    constexpr int L_V = L_K + 16384;
    int tid_ = threadIdx.x; asm volatile("" : "+v"(tid_) :: "memory");
    const int tid = tid_, wave = tid >> 6, lane = tid & 63, n = lane & 31, h2 = lane >> 5;
    LAS float* btab = (LAS float*)(lds + L_BT);
    for (int i = tid; i < 8 * 257; i += NTHREADS) { const int hq = i / 257, r = i % 257; btab[hq * 260 + r] = p.rel_bias[t5_bucket(r - 128) * 8 + hq] * LOG2E; }
    __syncthreads();
#pragma unroll 1
    for (int it = bidx; it < 512; it += nblk) {
        const int span = it & 63, kvh = (it >> 6) & 1, b = it >> 7;
        const int gq = wave & 3, hq = kvh * 4 + gq, q0 = span * 64 + (wave >> 2) * 32;
        const int kbase = span * 64 - 128;
        const int skey = tid >> 4, sc16 = tid & 15, sd = tid >> 2, sc4 = tid & 3;
        const bf16_t* kg = p.AK + ((size_t)b * S + skey) * 256 + kvh * 128 + sc16 * 8;
        const bf16_t* vg = p.AVT + (size_t)(kvh * 128 + sd) * T + (size_t)b * S + sc4 * 8;
        const int kdst = L_K + skey * 256 + ((sc16 ^ (skey & 15)) << 4), vdst = L_V + sd * 72 + sc4 * 16;
        u32x4 kst, vst;
        auto tile_ok = [&](int j) { const int k0 = kbase + 32 * j; return k0 >= 0 && k0 < S; };
        auto issue = [&](int j) { const int k0 = kbase + 32 * j; if (k0 >= 0 && k0 < S) { kst = *(const u32x4*)(kg + (size_t)k0 * 256); vst = *(const u32x4*)(vg + k0); } };
        auto stage = [&](int buf) { *(LAS u32x4*)(lds + buf * 8192 + kdst) = kst;
                                    *(LAS u32x2*)(lds + buf * 9216 + vdst) = (u32x2){vst.x, vst.y}; *(LAS u32x2*)(lds + buf * 9216 + vdst + 8) = (u32x2){vst.z, vst.w}; };
        bf16x8 qf[8];
        {
            const bf16_t* qrow = p.AQ + ((size_t)b * S + q0 + n) * 1024 + hq * 128 + 8 * h2;
#pragma unroll
            for (int ks = 0; ks < 8; ++ks) qf[ks] = *(const bf16x8*)(qrow + 16 * ks);
        }
        f32x16 o[4];
#pragma unroll
        for (int mt = 0; mt < 4; ++mt)
#pragma unroll
            for (int r = 0; r < 16; ++r) o[mt][r] = 0.f;
        float m = p.attn_sink[hq] * LOG2E, l = h2 ? 0.f : 1.f;
        const LAS float* bt = btab + hq * 260 + 128;
        issue(0);
        if (tile_ok(0)) stage(0);
        __syncthreads();
#pragma unroll 1
        for (int j = 0; j < 10; ++j) {
            if (j + 1 < 10) issue(j + 1);
            const int k0 = kbase + 32 * j, kt = (k0 - q0) / 32;
            if (k0 >= 0 && k0 < S && kt >= -4 && kt <= 4) {
                const LAS unsigned char* kb = lds + (j & 1) * 8192 + L_K;
                const LAS unsigned char* vb = lds + (j & 1) * 9216 + L_V;
                f32x16 s;
#pragma unroll
                for (int r = 0; r < 16; ++r) s[r] = 0.f;
#pragma unroll
                for (int ks = 0; ks < 8; ++ks) {
                    const bf16x8 kf = *(const LAS bf16x8*)(kb + n * 256 + (((2 * ks + h2) ^ (n & 15)) << 4));
                    s = mfma32(kf, qf[ks], s);
                }
                u32x2 vf[2][4][2];
#pragma unroll
                for (int ss = 0; ss < 2; ++ss)
#pragma unroll
                    for (int mt = 0; mt < 4; ++mt) {
                        const LAS unsigned char* vr = vb + (32 * mt + n) * 72 + (16 * ss + 4 * h2) * 2;
                        vf[ss][mt][0] = *(const LAS u32x2*)vr; vf[ss][mt][1] = *(const LAS u32x2*)(vr + 16);
                    }
                float tmax = -INFINITY;
#pragma unroll
                for (int r = 0; r < 16; ++r) {
                    const int kr = (r & 3) + 8 * (r >> 2) + 4 * h2, rel = 32 * kt + kr - n;
                    const int ri = rel < -128 ? -128 : (rel > 128 ? 128 : rel);
                    float v = fmaf(s[r], C1, bt[ri]);
                    v = (rel >= -128 && rel <= 128) ? v : -INFINITY;
                    s[r] = v; tmax = fmaxf(tmax, v);
                }
                tmax = fmaxf(tmax, __shfl_xor(tmax, 32));
                const float mn = fmaxf(m, tmax), alpha = __builtin_amdgcn_exp2f(m - mn);
                m = mn; l *= alpha;
#pragma unroll
                for (int mt = 0; mt < 4; ++mt) o[mt] = o[mt] * alpha;
#pragma unroll
                for (int r = 0; r < 16; ++r) { const float pr = __builtin_amdgcn_exp2f(s[r] - mn); l += pr; s[r] = pr; }
#pragma unroll
                for (int ss = 0; ss < 2; ++ss) {
                    u32x4 pw; pw.x = cvt_pk_bf16(s[8 * ss], s[8 * ss + 1]); pw.y = cvt_pk_bf16(s[8 * ss + 2], s[8 * ss + 3]); pw.z = cvt_pk_bf16(s[8 * ss + 4], s[8 * ss + 5]); pw.w = cvt_pk_bf16(s[8 * ss + 6], s[8 * ss + 7]);
                    const bf16x8 pf = __builtin_bit_cast(bf16x8, pw);
#pragma unroll
                    for (int mt = 0; mt < 4; ++mt) {
                        const u32x4 vw = (u32x4){vf[ss][mt][0].x, vf[ss][mt][0].y, vf[ss][mt][1].x, vf[ss][mt][1].y};
                        o[mt] = mfma32(__builtin_bit_cast(bf16x8, vw), pf, o[mt]);
                    }
                }
            }
            if (j + 1 < 10 && tile_ok(j + 1)) stage((j + 1) & 1);
            __syncthreads();
        }
        const float inv = 1.0f / (l + __shfl_xor(l, 32));
        bf16_t* orow = p.MIX + ((size_t)b * S + q0 + n) * 2048 + hq * 128 + 4 * h2;
#pragma unroll
        for (int mt = 0; mt < 4; ++mt)
#pragma unroll
            for (int r4 = 0; r4 < 4; ++r4) {
                u32x2 w; w.x = cvt_pk_bf16(o[mt][4 * r4] * inv, o[mt][4 * r4 + 1] * inv); w.y = cvt_pk_bf16(o[mt][4 * r4 + 2] * inv, o[mt][4 * r4 + 3] * inv);
                *(u32x2*)(orow + 32 * mt + 8 * r4) = w;
            }
    }
    __syncthreads();
}

template <int N> __device__ __forceinline__ void sort_desc(float (&v)[N]) {
#pragma unroll
    for (int k = 2; k <= N; k <<= 1)
#pragma unroll
        for (int j = k >> 1; j > 0; j >>= 1)
#pragma unroll
            for (int i = 0; i < N; ++i) {
                const int l = i ^ j;
                if (l > i) {
                    const float hi = fmaxf(v[i], v[l]), lo = fminf(v[i], v[l]);
                    if ((i & k) == 0) { v[i] = hi; v[l] = lo; } else { v[i] = lo; v[l] = hi; }
                }
            }
}
template <int XORMASK> __device__ __forceinline__ void merge_top16(float (&a)[16]) {
    float c[16];
#pragma unroll
    for (int i = 0; i < 16; ++i) c[i] = fmaxf(a[i], __shfl_xor(a[15 - i], XORMASK));
#pragma unroll
    for (int j = 8; j > 0; j >>= 1)
#pragma unroll
        for (int i = 0; i < 16; ++i) { const int l = i ^ j; if (l > i) { const float hi = fmaxf(c[i], c[l]), lo = fminf(c[i], c[l]); c[i] = hi; c[l] = lo; } }
#pragma unroll
    for (int i = 0; i < 16; ++i) a[i] = c[i];
}
__device__ __forceinline__ float sel4(int g, float x0, float x1, float x2, float x3) { const float lo = (g & 1) ? x1 : x0, hi = (g & 1) ? x3 : x2; return (g & 2) ? hi : lo; }

typedef __bf16 bf2_t __attribute__((ext_vector_type(2)));
__device__ __forceinline__ float dot2bf(unsigned a, unsigned b, float c) { return __builtin_amdgcn_fdot2_f32_bf16(__builtin_bit_cast(bf2_t, a), __builtin_bit_cast(bf2_t, b), c, false); }
__device__ __forceinline__ float gelu_erf(float d) { return 0.5f * d * (1.0f + erff(d * 0.7071067811865476f)); }

typedef float f32x32v __attribute__((ext_vector_type(32)));
__device__ __forceinline__ void convert_rows_fp4(const float* __restrict__ src, unsigned char* __restrict__ dst, float* __restrict__ scales, int nrows, int gw, int ngw, int lane) {
    for (int row = gw; row < nrows; row += ngw) {
        const float* r = src + (size_t)row * 2048 + 4 * lane;
        f32x4 v[8]; float amax = 0.f;
#pragma unroll
        for (int j = 0; j < 8; ++j) { v[j] = __builtin_nontemporal_load((const f32x4*)(r + 256 * j));
            amax = fmaxf(amax, fmaxf(fmaxf(fabsf(v[j][0]), fabsf(v[j][1])), fmaxf(fabsf(v[j][2]), fabsf(v[j][3])))); }
        amax = wave_max(amax);
        const float sc = amax > 0.f ? 6.0f / amax : 1.0f;
        u32x4 w;
#pragma unroll
        for (int d = 0; d < 4; ++d) {
            unsigned x = 0;
            x = __builtin_amdgcn_cvt_scalef32_pk_fp4_f32(x, v[2 * d][0] * sc, v[2 * d][1] * sc, 1.0f, 0);
            x = __builtin_amdgcn_cvt_scalef32_pk_fp4_f32(x, v[2 * d][2] * sc, v[2 * d][3] * sc, 1.0f, 1);
            x = __builtin_amdgcn_cvt_scalef32_pk_fp4_f32(x, v[2 * d + 1][0] * sc, v[2 * d + 1][1] * sc, 1.0f, 2);
            x = __builtin_amdgcn_cvt_scalef32_pk_fp4_f32(x, v[2 * d + 1][2] * sc, v[2 * d + 1][3] * sc, 1.0f, 3);
            w[d] = x;
        }
        *(u32x4*)(dst + (size_t)row * 1024 + 16 * lane) = w;
        if (lane == 0) scales[row] = 1.0f / sc;
    }
}

__device__ __forceinline__ void dec_fp4_row(const u32x4 w, f32x2 (&o)[16]) {
#define DEC4(d) o[4 * d] = __builtin_amdgcn_cvt_scalef32_pk_f32_fp4(w[d], 1.0f, 0); o[4 * d + 1] = __builtin_amdgcn_cvt_scalef32_pk_f32_fp4(w[d], 1.0f, 1); \
                o[4 * d + 2] = __builtin_amdgcn_cvt_scalef32_pk_f32_fp4(w[d], 1.0f, 2); o[4 * d + 3] = __builtin_amdgcn_cvt_scalef32_pk_f32_fp4(w[d], 1.0f, 3);
    DEC4(0) DEC4(1) DEC4(2) DEC4(3)
#undef DEC4
}

template <int CTRL> __device__ __forceinline__ float dpp_src(float v) { return __int_as_float(__builtin_amdgcn_update_dpp(0, __float_as_int(v), CTRL, 0xF, 0xF, true)); }
__device__ __forceinline__ float reduce16_rows(const float (&d)[16], int lane) {
    float e1[8], e2[4], e3[2];
#pragma unroll
    for (int r = 0; r < 8; ++r) { const float x = d[r] + dpp_src<0x140>(d[r]), y = d[r + 8] + dpp_src<0x140>(d[r + 8]); e1[r] = (lane & 8) ? y : x; }
#pragma unroll
    for (int r = 0; r < 4; ++r) { const float x = e1[r] + dpp_src<0x141>(e1[r]), y = e1[r + 4] + dpp_src<0x141>(e1[r + 4]); e2[r] = (lane & 4) ? y : x; }
#pragma unroll
    for (int r = 0; r < 2; ++r) { const float x = e2[r] + dpp_src<0x1B>(e2[r]), y = e2[r + 2] + dpp_src<0x1B>(e2[r + 2]); e3[r] = (lane & 2) ? y : x; }
    const float x = e3[0] + dpp_src<0xB1>(e3[0]), y = e3[1] + dpp_src<0xB1>(e3[1]);
    float tot = (lane & 1) ? y : x;
    tot += __shfl_xor(tot, 16);
    tot += __shfl_xor(tot, 32);
    return tot;
}

__device__ __forceinline__ void gather_token(const Params& p, int t, int e0, int e1, float g0, float g1, int lane) {
    asm volatile("" : "+v"(lane) :: "memory");
    f32x32v hv;
    {
        const bf16_t* prow = p.PREB + (size_t)t * 2048 + 4 * lane;
        float mean, rstd;
        { const f32x2 pq = lane < 32 ? *(const f32x2*)(p.PART + (size_t)t * 64 + 2 * lane) : (f32x2){0.f, 0.f};
          mean = wave_sum(pq.x) * (1.0f / 2048.0f); const float var = fmaxf(wave_sum(pq.y) * (1.0f / 2048.0f) - mean * mean, 0.f); rstd = 1.0f / sqrtf(var + LN_EPS); }
#pragma unroll
        for (int j = 0; j < 8; ++j) {
            const u32x2 xb2 = __builtin_nontemporal_load((const u32x2*)(prow + 256 * j));
            const f32x4 x = (f32x4){__uint_as_float(xb2.x << 16), __uint_as_float(xb2.x & 0xffff0000u), __uint_as_float(xb2.y << 16), __uint_as_float(xb2.y & 0xffff0000u)};
            const f32x4 gg = *(const f32x4*)(p.ln1_g + 4 * lane + 256 * j), bb = *(const f32x4*)(p.ln1_b + 4 * lane + 256 * j);
            const f32x4 hh = (x - mean) * rstd * gg + bb;
            hv[4 * j] = hh[0]; hv[4 * j + 1] = hh[1]; hv[4 * j + 2] = hh[2]; hv[4 * j + 3] = hh[3];
        }
    }
    const float us0 = p.US[e0], us1 = p.US[e1], vs0 = p.VS[e0], vs1 = p.VS[e1];
    float c0 = 0.f, c1 = 0.f;
    u32x4 rb[4][4];
#define PG_ROW(TAB, PICK) (*(const u32x4*)((TAB) + (size_t)__builtin_amdgcn_readlane((PICK) < 64 ? e0 : e1, (PICK) & 63) * 1024 + 16 * lane))
#pragma unroll
    for (int q = 0; q < 4; ++q)
#pragma unroll
        for (int r = 0; r < 4; ++r) rb[q][r] = PG_ROW(p.U8, 4 * q + r);
#pragma unroll 1
    for (int it = 0; it < 8; ++it) {
        const unsigned char* ntab = it < 7 ? p.U8 : p.V8;
        float dd[16];
#pragma unroll
        for (int q = 0; q < 4; ++q) {
            const int pp = 16 * it + 4 * q;
#pragma unroll
            for (int r = 0; r < 4; ++r) {
                f32x2 da = (f32x2){0.f, 0.f}, db = (f32x2){0.f, 0.f}, uv[16];
                dec_fp4_row(rb[q][r], uv);
#pragma unroll
                for (int k = 0; k < 32; k += 4) {
                    da = __builtin_elementwise_fma(uv[k >> 1], (f32x2){hv[k], hv[k + 1]}, da);
                    db = __builtin_elementwise_fma(uv[(k >> 1) + 1], (f32x2){hv[k + 2], hv[k + 3]}, db);
                }
                dd[4 * q + r] = (da.x + da.y) + (db.x + db.y);
            }
#pragma unroll
            for (int r = 0; r < 4; ++r) rb[q][r] = PG_ROW(ntab, (pp + 16 + r) & 127);
        }
        const float tot = reduce16_rows(dd, lane);
        if ((lane >> 4) == (it & 3)) { if (it < 4) c0 = tot; else c1 = tot; }
    }
    c0 = gelu_erf(c0 * us0) * g0 * vs0; c1 = gelu_erf(c1 * us1) * g1 * vs1;
    f32x32v acc;
#pragma unroll
    for (int k = 0; k < 32; ++k) acc[k] = 0.f;
#pragma unroll 1
    for (int it = 0; it < 8; ++it) {
#pragma unroll
        for (int q = 0; q < 4; ++q) {
            const int pp = 16 * it + 4 * q;
#pragma unroll
            for (int r = 0; r < 4; ++r) {
                const float cf = __uint_as_float(__builtin_amdgcn_readlane(__float_as_uint(pp < 64 ? c0 : c1), (pp + r) & 63));
                const f32x2 cf2 = (f32x2){cf, cf};
                f32x2 vv[16];
                dec_fp4_row(rb[q][r], vv);
#pragma unroll
                for (int k = 0; k < 32; k += 2) {
                    const f32x2 a2 = __builtin_elementwise_fma(vv[k >> 1], cf2, (f32x2){acc[k], acc[k + 1]});
                    acc[k] = a2.x; acc[k + 1] = a2.y;
                }
            }
            if (it < 7) {
#pragma unroll
                for (int r = 0; r < 4; ++r) rb[q][r] = PG_ROW(p.V8, pp + 16 + r);
            }
        }
    }
#undef PG_ROW
    float s = 0.f;
#pragma unroll
    for (int k = 0; k < 32; ++k) { acc[k] = acc[k] + ALPHA * hv[k]; s += acc[k]; }
    const float mean2 = wave_sum(s) * (1.0f / 2048.0f);
    float q2 = 0.f;
#pragma unroll
    for (int k = 0; k < 32; ++k) { acc[k] = acc[k] - mean2; q2 = fmaf(acc[k], acc[k], q2); }
    const float rstd2 = 1.0f / sqrtf(wave_sum(q2) * (1.0f / 2048.0f) + LN_EPS);
    float* orow = p.out + (size_t)t * 2048 + 4 * lane;
#pragma unroll
    for (int j = 0; j < 8; ++j) {
        const f32x4 g = *(const f32x4*)(p.ln2_g + 4 * lane + 256 * j), bb = *(const f32x4*)(p.ln2_b + 4 * lane + 256 * j);
        const f32x4 a4 = (f32x4){acc[4 * j], acc[4 * j + 1], acc[4 * j + 2], acc[4 * j + 3]};
        __builtin_nontemporal_store(a4 * rstd2 * g + bb, (f32x4*)(orow + 256 * j));
    }
}

__device__ __forceinline__ void phase_select_gather_impl(const Params& p, LAS unsigned char* lds) {
    constexpr int CA[52] = {0, 0, 0, 0, 0, 0, 0, 0, 0, 0, 0, 0, 0, 0, 0, 0, 1, 1, 1, 1, 1, 1, 1, 1, 2, 2, 2, 2, 2, 3, 3, 3, 3, 4, 4, 4, 5, 5, 6, 6, 7, 7, 8, 9, 10, 11, 12, 13, 14, 15, -1, -1};
    constexpr int CB[52] = {0, 1, 2, 3, 4, 5, 6, 7, 8, 9, 10, 11, 12, 13, 14, 15, 0, 1, 2, 3, 4, 5, 6, 7, 0, 1, 2, 3, 4, 0, 1, 2, 3, 0, 1, 2, 0, 1, 0, 1, 0, 1, 0, 0, 0, 0, 0, 0, 0, 0, -1, -1};
    constexpr int L_KEYS = 0;
    constexpr int L_TAB = 69632;
    constexpr int L_SCR = 69632 + 128;
    constexpr int L_PK = L_SCR + 8 * 2048;
    int tid_ = threadIdx.x; asm volatile("" : "+v"(tid_) :: "memory");
    const int tid = tid_, wave = tid >> 6, lane = tid & 63, n16 = lane & 15, g = lane >> 4;
    for (int i = tid; i < 2 * 128 * 16; i += NTHREADS) {
        const int row = i >> 4, c8 = i & 15;
        const f32x4 a = *(const f32x4*)(p.peer_keys + (size_t)row * 128 + c8 * 8), b = *(const f32x4*)(p.peer_keys + (size_t)row * 128 + c8 * 8 + 4);
        u32x4 o; o.x = cvt_pk_bf16(a[0], a[1]); o.y = cvt_pk_bf16(a[2], a[3]); o.z = cvt_pk_bf16(b[0], b[1]); o.w = cvt_pk_bf16(b[2], b[3]);
        *(LAS u32x4*)(lds + L_KEYS + row * 272 + c8 * 16) = o;
    }
    if (tid < 52) {
        int a = 0, b = 0;
#pragma unroll
        for (int c = 0; c < 52; ++c) if (tid == c) { a = CA[c] < 0 ? 0 : CA[c]; b = CB[c] < 0 ? 0 : CB[c]; }
        *(LAS unsigned char*)(lds + L_TAB + tid) = (unsigned char)a; *(LAS unsigned char*)(lds + L_TAB + 64 + tid) = (unsigned char)b;
    }
    __syncthreads();
    LAS float* scr = (LAS float*)(lds + L_SCR + wave * 2048);
    const int gw = blockIdx.x * 8 + wave, NGW = gridDim.x * 8;
    const int ntask = (T * 8 / 16 - gw + NGW - 1) / NGW;
    const bool typeB = (wave & 1) != 0;
#pragma unroll 1
    for (int j = 0; j < 2 * ntask; ++j) {
        const int ti = j >> 1, sub = j & 1;
        int selTask = -1;
        if (!typeB) { if (sub == 0) selTask = ti; }
        else { if (j == 0) selTask = 0; else if (sub == 1 && ti + 1 < ntask) selTask = ti + 1; }
        if (selTask >= 0) {
        int lane_s = lane; asm volatile("" : "+v"(lane_s) :: "memory");
        const int n16 = lane_s & 15, g = lane_s >> 4;
        const int task = gw + selTask * NGW;
        LAS int* pkidx = (LAS int*)(lds + L_PK + wave * 4096 + (selTask & 1) * 2048);
        LAS float* pkgate = (LAS float*)(lds + L_PK + wave * 4096 + (selTask & 1) * 2048 + 1024);
        const int item = task * 16 + n16, t = item >> 3, hd = item & 7;
        float sv[2][16];
#pragma unroll
        for (int pp = 0; pp < 2; ++pp) {
            bf16x8 qf[4];
            const bf16_t* qrow = p.QP + (size_t)t * 2048 + hd * 256 + pp * 128 + 8 * g;
#pragma unroll
            for (int ks = 0; ks < 4; ++ks) qf[ks] = __builtin_nontemporal_load((const bf16x8*)(qrow + 32 * ks));
            float v[32];
#pragma unroll
            for (int kt = 0; kt < 8; ++kt) {
                f32x4 acc = (f32x4){0.f, 0.f, 0.f, 0.f};
#pragma unroll
                for (int ks = 0; ks < 4; ++ks) {
                    const bf16x8 kf = *(const LAS bf16x8*)(lds + L_KEYS + (pp * 128 + 16 * kt + n16) * 272 + ks * 64 + g * 16);
                    acc = mfma16(kf, qf[ks], acc);
                }
#pragma unroll
                for (int rr = 0; rr < 4; ++rr) v[4 * kt + rr] = __uint_as_float((__float_as_uint(acc[rr]) & 0xFFFFFF80u) | (unsigned)(16 * kt + 4 * g + rr));
            }
            sort_desc<32>(v);
            float top[16];
#pragma unroll
            for (int r = 0; r < 16; ++r) top[r] = v[r];
            merge_top16<16>(top); merge_top16<32>(top);
#pragma unroll
            for (int r = 0; r < 16; ++r) sv[pp][r] = top[r];
        }
        if (g == 0) {
#pragma unroll
            for (int r = 0; r < 16; ++r) { scr[n16 * 32 + r] = sv[0][r]; scr[n16 * 32 + 16 + r] = sv[1][r]; }
        }
        float cs[16];
#pragma unroll
        for (int s = 0; s < 13; ++s) {
            const int c0 = 4 * s;
            const float a = sel4(g, sv[0][CA[c0] < 0 ? 0 : CA[c0]], sv[0][CA[c0 + 1] < 0 ? 0 : CA[c0 + 1]], sv[0][CA[c0 + 2] < 0 ? 0 : CA[c0 + 2]], sv[0][CA[c0 + 3] < 0 ? 0 : CA[c0 + 3]]);
            const float b = sel4(g, sv[1][CB[c0] < 0 ? 0 : CB[c0]], sv[1][CB[c0 + 1] < 0 ? 0 : CB[c0 + 1]], sv[1][CB[c0 + 2] < 0 ? 0 : CB[c0 + 2]], sv[1][CB[c0 + 3] < 0 ? 0 : CB[c0 + 3]]);
            float sum = __uint_as_float((__float_as_uint(a + b) & 0xFFFFFFC0u) | (unsigned)(c0 + g));
            if (s == 12) sum = (g >= 2) ? -INFINITY : sum;
            cs[s] = sum;
        }
        cs[13] = -INFINITY; cs[14] = -INFINITY; cs[15] = -INFINITY;
        sort_desc<16>(cs);
        merge_top16<16>(cs); merge_top16<32>(cs);
        float ts[16];
#pragma unroll
        for (int r = 0; r < 16; ++r) ts[r] = cs[r];
        float den = 0.f, e[16];
#pragma unroll
        for (int r = 0; r < 16; ++r) { e[r] = __expf(ts[r] - ts[0]); den += e[r]; }
        const float inv = 1.0f / den;
#pragma unroll
        for (int k = 0; k < 4; ++k) {
            const float tv = sel4(g, ts[k], ts[4 + k], ts[8 + k], ts[12 + k]);
            const float ev = sel4(g, e[k], e[4 + k], e[8 + k], e[12 + k]);
            const int c = (int)(__float_as_uint(tv) & 63u);
            const int a = *(const LAS unsigned char*)(lds + L_TAB + c), b = *(const LAS unsigned char*)(lds + L_TAB + 64 + c);
            const int e0 = (int)(__float_as_uint(scr[n16 * 32 + a]) & 127u), e1 = (int)(__float_as_uint(scr[n16 * 32 + 16 + b]) & 127u);
            const int oi = (n16 >> 3) * 128 + hd * 16 + 4 * g + k;
            pkidx[oi] = e0 * 128 + e1;
            pkgate[oi] = ev * inv;
        }
        asm volatile("s_waitcnt lgkmcnt(0)" ::: "memory");
        }
        {
            const LAS int* gidx = (const LAS int*)(lds + L_PK + wave * 4096 + (ti & 1) * 2048);
            const LAS float* ggate = (const LAS float*)(lds + L_PK + wave * 4096 + (ti & 1) * 2048 + 1024);
            const int ge0 = gidx[sub * 128 + lane], ge1 = gidx[sub * 128 + 64 + lane];
            const float gg0 = ggate[sub * 128 + lane], gg1 = ggate[sub * 128 + 64 + lane];
            gather_token(p, (gw + ti * NGW) * 2 + sub, ge0, ge1, gg0, gg1, lane);
        }
        asm volatile("s_waitcnt lgkmcnt(0)" ::: "memory");
    }
    __syncthreads();
}

__global__ void __launch_bounds__(NTHREADS, 2) mega(Params p) {
    extern __shared__ __attribute__((aligned(16))) unsigned char dyn_lds[];
    LAS unsigned char* lds = (LAS unsigned char*)dyn_lds;
    cg::grid_group grid = cg::this_grid();
    const int G = gridDim.x;
    volatile LAS unsigned* xbw = (volatile LAS unsigned*)(lds + LDS_BYTES - 16);
    if (threadIdx.x == 0) { xbw[0] = 0u; xbw[1] = 0u; }
    __syncthreads();
    const XcdBarrier xb = xcd_barrier_post(p.BAR, xbw);
    phase_prep(p, lds);
    xcd_barrier(xb);
    { pg8::Gemm g{p.R, p.R, D}; pg8::ProjOrder so; so.init(G, blockIdx.x);
      pg8::EpiProj E{p.AQ, p.AK, p.AVT, p.DQ, p.DK, p.DV, p.DZ, p.BG};
      pg8::gemm_phase(lds, g, so, E); }
    xcd_barrier(xb);
    phase_dnprep<0>(p, lds);
    xcd_barrier(xb);
    if (blockIdx.x < 64) phase_dnscan(p, lds);
    else {
        phase_dnprep<1>(p, lds);
        phase_attn(p, lds, blockIdx.x - 64, G - 64);
        phase_prep_late(p, lds, blockIdx.x - 64, G - 64);
        int tid_ = threadIdx.x; asm volatile("" : "+v"(tid_) :: "memory");
        const int wave = tid_ >> 6, lane = tid_ & 63, gw = (blockIdx.x - 64) * 8 + wave, ngw = (G - 64) * 8;
        convert_rows_fp4(p.peer_u, p.U8, p.US, 16384, gw, ngw, lane);
        convert_rows_fp4(p.peer_v, p.V8, p.VS, 16384, gw, ngw, lane);
    }
    grid.sync();
    phase_dncombine(p);
    xcd_barrier(xb);
    { pg8::Gemm g{p.MIX, p.WOUTT, D}; pg8::StaticOrder so; so.init(64, 8, G, blockIdx.x);
      pg8::EpiResBf16 E{p.PREB, p.x, D, ALPHA, p.PART};
      pg8::gemm_phase(lds, g, so, E); }
    xcd_barrier(xb);
    { pg8::Gemm g{p.PREB, p.WQT, D}; pg8::StaticOrder so; so.init(64, 8, G, blockIdx.x);
      pg8::EpiLnQ E{p.QP, D, p.PART, p.CS, p.BW};
      pg8::gemm_phase(lds, g, so, E); }
    xcd_barrier(xb);
    phase_select_gather_impl(p, lds);
}
}

extern "C" void kernel_launch(void* const* d_in, const int* in_sizes, int n_in, void* d_out, int out_size, void* d_ws, size_t ws_size, hipStream_t stream) {
    if (n_in != 17 || out_size != T * D || ws_size < 500 * MB) { fprintf(stderr, "kernel_launch: unexpected sizes n_in %d out %d ws %zu\n", n_in, out_size, ws_size); return; }
    static int grid_blocks = 0;
    if (!grid_blocks) {
        int dev = 0, cus = 0, per_cu = 0;
        (void)hipGetDevice(&dev);
        (void)hipDeviceGetAttribute(&cus, hipDeviceAttributeMultiprocessorCount, dev);
        if (hipFuncSetAttribute((const void*)mega, hipFuncAttributeMaxDynamicSharedMemorySize, LDS_BYTES) != hipSuccess) fprintf(stderr, "kernel_launch: hipFuncSetAttribute failed\n");
        (void)hipOccupancyMaxActiveBlocksPerMultiprocessor(&per_cu, (const void*)mega, NTHREADS, LDS_BYTES);
        if (per_cu < 1) { fprintf(stderr, "kernel_launch: occupancy query says %d\n", per_cu); per_cu = 1; }
        grid_blocks = cus;
        fprintf(stderr, "kernel_launch: cus %d per_cu %d grid %d\n", cus, per_cu, grid_blocks);
    }
    char* ws = (char*)d_ws;
    Params p;
    memset(&p, 0, sizeof(p));
    p.x = (const float*)d_in[0]; p.w_in = (const float*)d_in[1]; p.conv_w = (const float*)d_in[2]; p.a_log = (const float*)d_in[3]; p.dt_bias = (const float*)d_in[4];
    p.dn_norm_w = (const float*)d_in[5]; p.attn_sink = (const float*)d_in[6]; p.rel_bias = (const float*)d_in[7]; p.w_out = (const float*)d_in[8];
    p.ln1_g = (const float*)d_in[9]; p.ln1_b = (const float*)d_in[10]; p.peer_wq = (const float*)d_in[11]; p.peer_keys = (const float*)d_in[12];
    p.peer_u = (const float*)d_in[13]; p.peer_v = (const float*)d_in[14]; p.ln2_g = (const float*)d_in[15]; p.ln2_b = (const float*)d_in[16];
    p.out = (float*)d_out;
    p.R = (bf16_t*)(ws + 0 * MB);
    p.AQ = (bf16_t*)(ws + 88 * MB);
    p.AK = (bf16_t*)(ws + 120 * MB);
    p.AVT = (bf16_t*)(ws + 128 * MB);
    p.DQ = (bf16_t*)(ws + 136 * MB);
    p.DK = (bf16_t*)(ws + 168 * MB);
    p.DV = (bf16_t*)(ws + 200 * MB);
    p.DZ = (bf16_t*)(ws + 232 * MB);
    p.BG = (float*)(ws + 264 * MB);
    p.WOUTT = (bf16_t*)(ws + 266 * MB);
    p.WQT = (bf16_t*)(ws + 274 * MB);
    p.MIX = (bf16_t*)(ws + 0 * MB);
    p.DND = (unsigned char*)(ws + 282 * MB);
    p.DNS = (unsigned char*)d_out + 64 * MB;
    p.OF = (bf16_t*)d_out;
    p.OB = (bf16_t*)((char*)d_out + 32 * MB);
    p.PREB = (bf16_t*)(ws + 282 * MB);
    p.HB = (bf16_t*)(ws + 0 * MB);
    p.QP = (bf16_t*)(ws + 66 * MB);
    p.EIDX = (int*)(ws + 346 * MB);
    p.GATE = (float*)(ws + 354 * MB);
    p.V8 = (unsigned char*)(ws + 446 * MB);
    p.U8 = (unsigned char*)(ws + 462 * MB);
    p.US = (float*)(ws + 478 * MB);
    p.VS = (float*)(ws + 479 * MB);
    p.PART = (float*)(ws + 202 * MB);
    p.PCS = (float*)(ws + 480 * MB);
    p.PBW = (float*)(ws + 481 * MB);
    p.CS = (float*)(ws + 208 * MB);
    p.BW = (float*)(ws + 208 * MB + 16384);
    p.BAR = (unsigned*)(ws + 490 * MB);
    p.FLAG = p.BAR + 4096;
    (void)hipMemsetAsync(p.BAR, 0, (4096 + 2048) * 4, stream);
    void* args[] = {&p};
    hipError_t e = hipLaunchCooperativeKernel((const void*)mega, dim3(grid_blocks), dim3(NTHREADS), args, LDS_BYTES, stream);
    if (e != hipSuccess) fprintf(stderr, "cooperative launch failed: %s (grid %d)\n", hipGetErrorString(e), grid_blocks);
}
```

```cpp
#include <hip/hip_runtime.h>
#include <hip/hip_cooperative_groups.h>
#include <cstdio>
#include <cstdint>
#include <cmath>
#include <cstring>

namespace {
namespace cg = cooperative_groups;
#define LAS __attribute__((address_space(3)))
typedef unsigned short bf16_t;
typedef short bf16x8 __attribute__((ext_vector_type(8)));
typedef float f32x4 __attribute__((ext_vector_type(4)));
typedef float f32x2 __attribute__((ext_vector_type(2)));
typedef unsigned u32x4 __attribute__((ext_vector_type(4)));
typedef unsigned u32x2 __attribute__((ext_vector_type(2)));

constexpr int D = 2048, NB = 4, S = 4096, T = NB * S;
constexpr int INW = 5664;
constexpr float ALPHA = 1.189207115002721f;
constexpr float LN_EPS = 1e-5f, RMS_EPS = 1e-6f;
constexpr size_t MB = 1024ull * 1024ull;
constexpr int NTHREADS = 512;
constexpr int LDS_BYTES = 134 * 1024;

template <int CTRL> __device__ __forceinline__ float dpp_get(float v) { return __int_as_float(__builtin_amdgcn_update_dpp(0, __float_as_int(v), CTRL, 0xF, 0xF, true)); }
__device__ __forceinline__ float wave_sum(float v) {
    v += dpp_get<0xB1>(v); v += dpp_get<0x4E>(v); v += dpp_get<0x141>(v); v += dpp_get<0x140>(v);
    v += __shfl_xor(v, 16); v += __shfl_xor(v, 32);
    return v;
}
__device__ __forceinline__ float wave_max(float v) {
    v = fmaxf(v, dpp_get<0xB1>(v)); v = fmaxf(v, dpp_get<0x4E>(v)); v = fmaxf(v, dpp_get<0x141>(v)); v = fmaxf(v, dpp_get<0x140>(v));
    v = fmaxf(v, __shfl_xor(v, 16)); v = fmaxf(v, __shfl_xor(v, 32));
    return v;
}
__device__ __forceinline__ float silu_f(float x) { return x * __builtin_amdgcn_rcpf(1.0f + __builtin_amdgcn_exp2f(-1.4426950408889634f * x)); }
__device__ __forceinline__ float sigmoid_f(float x) { return 1.0f / (1.0f + expf(-x)); }
__device__ __forceinline__ float softplus_f(float x) { return fmaxf(x, 0.f) + log1pf(expf(-fabsf(x))); }
__device__ __forceinline__ float bf2f(bf16_t v) { return __uint_as_float(((unsigned)v) << 16); }
__device__ __forceinline__ float ldf(const float* p) { return *p; }
__device__ __forceinline__ float ldf(const bf16_t* p) { return bf2f(*p); }
typedef __bf16 bf16x2_t __attribute__((ext_vector_type(2)));
__device__ __forceinline__ unsigned cvt_pk_bf16(float lo, float hi) { const f32x2 v = {lo, hi}; return __builtin_bit_cast(unsigned, __builtin_convertvector(v, bf16x2_t)); }
constexpr int GEMM_MBITS = 4;
__device__ __forceinline__ float rmb(float x) { constexpr int sh = 23 - GEMM_MBITS; unsigned u = __float_as_uint(x); u += ((u >> sh) & 1u) + (1u << (sh - 1)) - 1u; u &= ~((1u << sh) - 1u); return __uint_as_float(u); }
__device__ __forceinline__ bf16_t f2bf(float f) { return (bf16_t)(cvt_pk_bf16(f, 0.f) & 0xffffu); }
__device__ __forceinline__ int t5_bucket(int rel) {
    int n = rel < 0 ? -rel : rel;
    int v;
    if (n < 8) v = n; else if (n < 12) v = 8; else if (n < 16) v = 9; else if (n < 23) v = 10; else if (n < 32) v = 11;
    else if (n < 46) v = 12; else if (n < 64) v = 13; else if (n < 91) v = 14; else v = 15;
    return v + (rel > 0 ? 16 : 0);
}

namespace pg8 {
constexpr int BM = 256, BK = 64, HALF = 128, HTB = HALF * BK * 2, STAGE_BYTES = 8 * HTB, NXCD = 8, WGM = 8;
__host__ __device__ __forceinline__ int lds_byte(int r, int c) { const int st = (r >> 4) * 2 + (c >> 5), rr = r & 15, cc = c & 31, ob = rr * 64 + cc * 2; return st * 1024 + (ob ^ (((ob >> 9) & 1) << 5)); }
__host__ __device__ __forceinline__ void stage_rc(int b, int& R, int& C) { const int st = b / 1024, sb = b % 1024, swz = sb ^ (((sb >> 9) & 1) << 5); R = (st >> 1) * 16 + swz / 64; C = (st & 1) * 32 + (swz % 64) / 2; }
__host__ __device__ __forceinline__ int perm32(int rho) { const int n = rho >> 4, i = rho & 15; return 8 * (i >> 2) + 4 * n + (i & 3); }
struct Unit { int pm, pn; };
struct Gemm { const bf16_t* A; const bf16_t* Bt; int K; };
struct StaticOrder {
    int nM, nN, nwg, G, c;
    __device__ void init(int nM_, int nN_, int G_, int c_) { nM = nM_; nN = nN_; nwg = nM * nN; G = G_; c = c_; }
    __device__ bool next(int i, Unit& u) const {
        const long L = (long)i * G + c; if (L >= nwg) return false;
        int wgid = (int)L; { const int q = nwg / NXCD, r = nwg % NXCD, xcd = wgid % NXCD, off = wgid / NXCD; wgid = (xcd < r ? xcd * (q + 1) : r * (q + 1) + (xcd - r) * q) + off; }
        const int nig = WGM * nN, gid = wgid / nig, fm = gid * WGM, gsz = (nM - fm) < WGM ? (nM - fm) : WGM;
        u.pm = fm + ((wgid % nig) % gsz); u.pn = (wgid % nig) / gsz; return true;
    }
};
struct ProjOrder {
    StaticOrder so; int G, c;
    __device__ void init(int G_, int c_) { so.init(64, 22, G_, c_); G = G_; c = c_; }
    __device__ bool next(int i, Unit& u) const {
        const long L = (long)i * G + c;
        if (L < 1408) { so.next(i, u); u.pn = 64 + (u.pn < 5 ? u.pn : u.pn + 1); return true; }
        if (L < 1472) { u.pm = 69; u.pn = (int)(L - 1408); return true; }
        return false;
    }
};

struct EpiProj {
    static constexpr bool PERM = true, HAS_PRE = false;
    bf16_t *AQ, *AK, *AVT, *DQ, *DK, *DV, *DZ; float* BG;
    __device__ __forceinline__ void operator()(const f32x4 (&acc)[2][2][4][2], const Unit& u, int wr, int wc, int fr, int fq) const {
        bf16_t* base; int ldc; int colt; int rowt;
        if (u.pm == 69) { base = AVT; ldc = T; colt = u.pn * BM; rowt = 0; }
        else {
            rowt = u.pm * BM; const int wt = u.pn - 64;
            if (wt == 22) {
                if (wc == 0) {
#pragma unroll
                    for (int ai = 0; ai < 2; ++ai)
#pragma unroll
                        for (int m = 0; m < 4; ++m) { float* rowp = BG + (size_t)(rowt + ai * HALF + wr * 64 + m * 16 + fr) * 32 + 8 * fq;
                            *(f32x4*)(rowp) = acc[ai][0][m][0]; *(f32x4*)(rowp + 4) = acc[ai][0][m][1]; }
                }
                return;
            }
            if (wt < 4) { base = AQ; ldc = 1024; colt = wt * 256; }
            else if (wt == 4) { base = AK; ldc = 256; colt = 0; }
            else if (wt < 10) { base = DQ; ldc = 1024; colt = (wt - 6) * 256; }
            else if (wt < 14) { base = DK; ldc = 1024; colt = (wt - 10) * 256; }
            else if (wt < 18) { base = DV; ldc = 1024; colt = (wt - 14) * 256; }
            else { base = DZ; ldc = 1024; colt = (wt - 18) * 256; }
        }
        const int row0 = rowt + wr * 64 + fr, col0 = colt + wc * 32 + 8 * fq;
#pragma unroll
        for (int ai = 0; ai < 2; ++ai)
#pragma unroll
            for (int m = 0; m < 4; ++m) { bf16_t* rowp = base + (size_t)(row0 + ai * HALF + m * 16) * ldc + col0;
#pragma unroll
                for (int bj = 0; bj < 2; ++bj) { const f32x4 v0 = acc[ai][bj][m][0], v1 = acc[ai][bj][m][1];
                    u32x4 w; w.x = cvt_pk_bf16(v0[0], v0[1]); w.y = cvt_pk_bf16(v0[2], v0[3]); w.z = cvt_pk_bf16(v1[0], v1[1]); w.w = cvt_pk_bf16(v1[2], v1[3]);
                    *(u32x4*)(rowp + bj * HALF) = w; } }
    }
};
struct EpiBf16 {
    static constexpr bool PERM = true, HAS_PRE = false;
    bf16_t* O; int ldc;
    __device__ __forceinline__ void operator()(const f32x4 (&acc)[2][2][4][2], const Unit& u, int wr, int wc, int fr, int fq) const {
        const int row0 = u.pm * BM + wr * 64 + fr, col0 = u.pn * BM + wc * 32 + 8 * fq;
#pragma unroll
        for (int ai = 0; ai < 2; ++ai)
#pragma unroll
            for (int m = 0; m < 4; ++m) { bf16_t* rowp = O + (size_t)(row0 + ai * HALF + m * 16) * ldc + col0;
#pragma unroll
                for (int bj = 0; bj < 2; ++bj) { const f32x4 v0 = acc[ai][bj][m][0], v1 = acc[ai][bj][m][1];
                    u32x4 w; w.x = cvt_pk_bf16(v0[0], v0[1]); w.y = cvt_pk_bf16(v0[2], v0[3]); w.z = cvt_pk_bf16(v1[0], v1[1]); w.w = cvt_pk_bf16(v1[2], v1[3]);
                    *(u32x4*)(rowp + bj * HALF) = w; } }
    }
};
struct EpiResF32 {
    static constexpr bool PERM = false, HAS_PRE = false;
    float* C; const float* X; int ldc; float alpha;
    __device__ __forceinline__ void operator()(const f32x4 (&acc)[2][2][4][2], const Unit& u, int wr, int wc, int fr, int fq) const {
        const int row0 = u.pm * BM + wr * 64 + fr, col0 = u.pn * BM + wc * 32 + 4 * fq;
        const float* __restrict__ Xr = X; float* __restrict__ Cr = C;
#pragma unroll
        for (int ai = 0; ai < 2; ++ai)
#pragma unroll
            for (int mp = 0; mp < 2; ++mp) {
                f32x4 xv[2][2][2];
#pragma unroll
                for (int mq = 0; mq < 2; ++mq) { const size_t off = (size_t)(row0 + ai * HALF + (2 * mp + mq) * 16) * ldc + col0;
#pragma unroll
                    for (int bj = 0; bj < 2; ++bj)
#pragma unroll
                        for (int n = 0; n < 2; ++n) xv[mq][bj][n] = __builtin_nontemporal_load((const f32x4*)(Xr + off + bj * HALF + n * 16)); }
#pragma unroll
                for (int mq = 0; mq < 2; ++mq) { const size_t off = (size_t)(row0 + ai * HALF + (2 * mp + mq) * 16) * ldc + col0;
#pragma unroll
                    for (int bj = 0; bj < 2; ++bj)
#pragma unroll
                        for (int n = 0; n < 2; ++n) *(f32x4*)(Cr + off + bj * HALF + n * 16) = acc[ai][bj][2 * mp + mq][n] + alpha * xv[mq][bj][n]; }
                asm volatile("" ::: "memory"); }
    }
};

struct EpiResBf16 {
    static constexpr bool PERM = true, HAS_PRE = false;
    bf16_t* O; const float* X; int ldc; float alpha; float* PART;
    __device__ __forceinline__ void operator()(const f32x4 (&acc)[2][2][4][2], const Unit& u, int wr, int wc, int fr, int fq) const {
        const int row0 = u.pm * BM + wr * 64 + fr, col0 = u.pn * BM + wc * 32 + 8 * fq;
        const float* __restrict__ Xr = X; bf16_t* __restrict__ Or = O;
        f32x4 xv[2][2][2][2];
#define ER_ISSUE(s_) { const int ai_ = (s_) >> 1, mp_ = (s_) & 1; \
            _Pragma("unroll") for (int mq = 0; mq < 2; ++mq) { const size_t off = (size_t)(row0 + ai_ * HALF + (2 * mp_ + mq) * 16) * ldc + col0; \
                _Pragma("unroll") for (int bj = 0; bj < 2; ++bj) { xv[(s_) & 1][mq][bj][0] = __builtin_nontemporal_load((const f32x4*)(Xr + off + bj * HALF)); xv[(s_) & 1][mq][bj][1] = __builtin_nontemporal_load((const f32x4*)(Xr + off + bj * HALF + 4)); } } }
        ER_ISSUE(0)
#pragma unroll
        for (int s = 0; s < 4; ++s) {
            const int ai = s >> 1, mp = s & 1;
            if (s < 3) ER_ISSUE(s + 1)
#pragma unroll
            for (int mq = 0; mq < 2; ++mq) { const int row = row0 + ai * HALF + (2 * mp + mq) * 16; const size_t off = (size_t)row * ldc + col0;
                float s1 = 0.f, s2 = 0.f;
#pragma unroll
                for (int bj = 0; bj < 2; ++bj) { const f32x4 v0 = acc[ai][bj][2 * mp + mq][0] + alpha * xv[s & 1][mq][bj][0], v1 = acc[ai][bj][2 * mp + mq][1] + alpha * xv[s & 1][mq][bj][1];
                    u32x4 w; w.x = cvt_pk_bf16(v0[0], v0[1]); w.y = cvt_pk_bf16(v0[2], v0[3]); w.z = cvt_pk_bf16(v1[0], v1[1]); w.w = cvt_pk_bf16(v1[2], v1[3]);
                    *(u32x4*)(Or + off + bj * HALF) = w;
#pragma unroll
                    for (int e = 0; e < 4; ++e) { const float lo = __uint_as_float(w[e] << 16), hi = __uint_as_float(w[e] & 0xffff0000u); s1 += lo + hi; s2 = fmaf(lo, lo, s2); s2 = fmaf(hi, hi, s2); } }
                s1 += __shfl_xor(s1, 16); s1 += __shfl_xor(s1, 32); s2 += __shfl_xor(s2, 16); s2 += __shfl_xor(s2, 32);
                if (fq == 0) *(f32x2*)(PART + (size_t)row * 64 + (u.pn * 4 + wc) * 2) = (f32x2){s1, s2}; }
            asm volatile("" ::: "memory"); }
#undef ER_ISSUE
    }
};
struct EpiLnQ {
    static constexpr bool PERM = true, HAS_PRE = true;
    bf16_t* O; int ldc; const float* PART; const float* CS; const float* BW;
    __device__ __forceinline__ void pre(LAS unsigned char* lds, const Unit& u, int ui) const {
        int tid = threadIdx.x; asm volatile("" : "+v"(tid));
        LAS float* tab = (LAS float*)(lds + STAGE_BYTES + (ui & 1) * 2048);
        if (tid < 256) {
            const f32x4* pp = (const f32x4*)(PART + (size_t)(u.pm * BM + tid) * 64);
            float s1 = 0.f, s2 = 0.f;
#pragma unroll
            for (int i = 0; i < 16; ++i) { const f32x4 v = pp[i]; s1 += v[0] + v[2]; s2 += v[1] + v[3]; }
            const float mean = s1 * (1.0f / 2048.0f), var = fmaxf(s2 * (1.0f / 2048.0f) - mean * mean, 0.f);
            tab[2 * tid] = mean; tab[2 * tid + 1] = 1.0f / sqrtf(var + 1e-5f);
        }
        asm volatile("s_waitcnt lgkmcnt(0)" ::: "memory"); __builtin_amdgcn_s_barrier(); asm volatile("" ::: "memory");
    }
    __device__ __forceinline__ void run(LAS unsigned char* lds, int ui, const f32x4 (&acc)[2][2][4][2], const Unit& u, int wr, int wc, int fr, int fq) const {
        const LAS f32x2* tab = (const LAS f32x2*)(lds + STAGE_BYTES + (ui & 1) * 2048);
        const int rl0 = wr * 64 + fr, col0 = u.pn * BM + wc * 32 + 8 * fq;
        f32x4 cs[2][2], bw[2][2];
#pragma unroll
        for (int bj = 0; bj < 2; ++bj)
#pragma unroll
            for (int n = 0; n < 2; ++n) { cs[bj][n] = *(const f32x4*)(CS + col0 + bj * HALF + 4 * n); bw[bj][n] = *(const f32x4*)(BW + col0 + bj * HALF + 4 * n); }
#pragma unroll
        for (int ai = 0; ai < 2; ++ai)
#pragma unroll
            for (int m = 0; m < 4; ++m) { const int rl = rl0 + ai * HALF + m * 16; const f32x2 st = tab[rl]; bf16_t* rowp = O + (size_t)(u.pm * BM + rl) * ldc + col0;
#pragma unroll
                for (int bj = 0; bj < 2; ++bj) { const f32x4 v0 = (acc[ai][bj][m][0] - st.x * cs[bj][0]) * st.y + bw[bj][0], v1 = (acc[ai][bj][m][1] - st.x * cs[bj][1]) * st.y + bw[bj][1];
                    u32x4 w; w.x = cvt_pk_bf16(v0[0], v0[1]); w.y = cvt_pk_bf16(v0[2], v0[3]); w.z = cvt_pk_bf16(v1[0], v1[1]); w.w = cvt_pk_bf16(v1[2], v1[3]);
                    *(u32x4*)(rowp + bj * HALF) = w; } }
    }
};

template <class Epi, class Sched>
__device__ __forceinline__ void gemm_phase(LAS unsigned char* lds, const Gemm g, const Sched& S, const Epi& E) {
    int tid_ = threadIdx.x; asm volatile("" : "+v"(tid_) :: "memory");
    const int tid = tid_, wid = __builtin_amdgcn_readfirstlane(tid >> 6), lane = tid & 63, wr = wid >> 2, wc = wid & 3, fr = lane & 15, fq = lane >> 4;
    const int K = g.K, nt = K / BK;
    unsigned voffA[2], voffB[2];
#pragma unroll
    for (int i = 0; i < 2; ++i) { int R, C; stage_rc(tid * 16 + i * 8192, R, C); const int Rb = Epi::PERM ? ((R & ~31) + perm32(R & 31)) : R;
        voffA[i] = (unsigned)(R * K + C) * 2u; voffB[i] = (unsigned)(Rb * K + C) * 2u; }
    const size_t kstep = (size_t)(BK * 2);
    const size_t hstep = (size_t)HALF * K * 2;
    const size_t tstep = 2 * hstep;
    const unsigned ldsw = (unsigned)wid * 1024u;
    const int aoff = lds_byte(wr * 64 + fr, fq * 8), boff = lds_byte(wc * 32 + fr, fq * 8);
#define PG8_SA(b, h) (((b) * 2 + (h)) * HTB)
#define PG8_SB(b, h) ((4 + (b) * 2 + (h)) * HTB)
#define PG8_STAGE(bufoff, gbase, voff) do { _Pragma("unroll") for (int _i = 0; _i < 2; ++_i) \
        __builtin_amdgcn_global_load_lds((const unsigned*)((const char*)(gbase) + (voff)[_i]), (LAS unsigned*)(lds + (bufoff) + ldsw + _i * 8192), 16, 0, 0); } while (0)
#define PG8_LDA(dst, b, h) do { _Pragma("unroll") for (int m = 0; m < 4; ++m) _Pragma("unroll") for (int k = 0; k < 2; ++k) dst[m][k] = *(const LAS bf16x8*)(lds + PG8_SA(b, h) + aoff + m * 2048 + k * 1024); } while (0)
#define PG8_LDB(dst, b, h) do { _Pragma("unroll") for (int n = 0; n < 2; ++n) _Pragma("unroll") for (int k = 0; k < 2; ++k) dst[n][k] = *(const LAS bf16x8*)(lds + PG8_SB(b, h) + boff + n * 2048 + k * 1024); } while (0)
#define PG8_MMA(ai, bj, At, Bt) do { __builtin_amdgcn_s_setprio(1); _Pragma("unroll") for (int m = 0; m < 4; ++m) _Pragma("unroll") for (int n = 0; n < 2; ++n) _Pragma("unroll") for (int k = 0; k < 2; ++k) \
        acc[ai][bj][m][n] = __builtin_amdgcn_mfma_f32_16x16x32_bf16(Bt[n][k], At[m][k], acc[ai][bj][m][n], 0, 0, 0); __builtin_amdgcn_s_setprio(0); } while (0)
#define PG8_WAIT_V(n) asm volatile("s_waitcnt vmcnt(" #n ")" ::: "memory")
#define PG8_WAIT_L(n) asm volatile("s_waitcnt lgkmcnt(" #n ")" ::: "memory")
#define PG8_BAR __builtin_amdgcn_s_barrier()
#define PG8_SCHED __builtin_amdgcn_sched_barrier(0)
    Unit cur, nxt; int ui = 0;
    if (!S.next(0, cur)) return;
    f32x4 acc[2][2][4][2];
#pragma unroll
    for (int a = 0; a < 2; ++a)
#pragma unroll
        for (int b = 0; b < 2; ++b)
#pragma unroll
            for (int m = 0; m < 4; ++m)
#pragma unroll
                for (int n = 0; n < 2; ++n) acc[a][b][m][n] = (f32x4){0.f, 0.f, 0.f, 0.f};
    bf16x8 At[4][2], B0[2][2], B1[2][2];
    const char* cA = (const char*)g.A + (size_t)cur.pm * tstep; const char* cB = (const char*)g.Bt + (size_t)cur.pn * tstep;
    PG8_STAGE(PG8_SB(0, 0), cB, voffB); PG8_STAGE(PG8_SA(0, 0), cA, voffA); PG8_STAGE(PG8_SB(0, 1), cB + hstep, voffB); PG8_STAGE(PG8_SA(0, 1), cA + hstep, voffA);
    if constexpr (Epi::HAS_PRE) {
        Unit u1; const bool h1 = S.next(1, u1);
        E.pre(lds, cur, 0);
        if (h1) E.pre(lds, u1, 1);
    }
    if (wr == 1) PG8_BAR;
    PG8_WAIT_V(4); PG8_BAR;
    PG8_STAGE(PG8_SB(1, 0), cB + kstep, voffB); PG8_STAGE(PG8_SA(1, 0), cA + kstep, voffA); PG8_STAGE(PG8_SB(1, 1), cB + hstep + kstep, voffB);
    PG8_WAIT_V(6); PG8_BAR;
    for (;;) {
        const bool has_next = S.next(ui + 1, nxt);
        const char* nA = has_next ? (const char*)g.A + (size_t)nxt.pm * tstep : cA; const char* nB = has_next ? (const char*)g.Bt + (size_t)nxt.pn * tstep : cB;
        for (int t = 0; t < nt; t += 2) {
            const bool last = (t == nt - 2);
            const char* a1 = cA + (size_t)(t + 1) * kstep;
            const char* a2 = last ? nA : cA + (size_t)(t + 2) * kstep; const char* b2 = last ? nB : cB + (size_t)(t + 2) * kstep;
            const char* a3 = a2 + kstep; const char* b3 = b2 + kstep;
            PG8_LDB(B0, 0, 0); PG8_SCHED; PG8_LDA(At, 0, 0); PG8_STAGE(PG8_SA(1, 1), a1 + hstep, voffA);
            PG8_WAIT_L(8); PG8_BAR; PG8_WAIT_L(0); PG8_MMA(0, 0, At, B0); PG8_BAR; PG8_SCHED;
            PG8_LDB(B1, 0, 1); PG8_STAGE(PG8_SB(0, 0), b2, voffB);
            PG8_BAR; PG8_WAIT_L(0); PG8_MMA(0, 1, At, B1); PG8_BAR;
            PG8_LDA(At, 0, 1); PG8_STAGE(PG8_SA(0, 0), a2, voffA);
            PG8_BAR; PG8_WAIT_L(0); PG8_MMA(1, 0, At, B0); PG8_BAR; PG8_SCHED;
            PG8_STAGE(PG8_SB(0, 1), b2 + hstep, voffB);
            PG8_WAIT_V(6); PG8_BAR; PG8_MMA(1, 1, At, B1); PG8_BAR;
            PG8_LDB(B0, 1, 0); PG8_SCHED; PG8_LDA(At, 1, 0); PG8_STAGE(PG8_SA(0, 1), a2 + hstep, voffA);
            PG8_WAIT_L(8); PG8_BAR; PG8_WAIT_L(0); PG8_MMA(0, 0, At, B0); PG8_BAR; PG8_SCHED;
            PG8_LDB(B1, 1, 1); PG8_STAGE(PG8_SB(1, 0), b3, voffB);
            PG8_BAR; PG8_WAIT_L(0); PG8_MMA(0, 1, At, B1); PG8_BAR;
            PG8_LDA(At, 1, 1); PG8_STAGE(PG8_SA(1, 0), a3, voffA);
            PG8_BAR; PG8_WAIT_L(0); PG8_MMA(1, 0, At, B0); PG8_BAR; PG8_SCHED;
            PG8_STAGE(PG8_SB(1, 1), b3 + hstep, voffB);
            PG8_WAIT_V(6); PG8_BAR; PG8_MMA(1, 1, At, B1); PG8_BAR;
        }
        if constexpr (Epi::HAS_PRE) { if (ui >= 2) E.pre(lds, cur, ui); E.run(lds, ui, acc, cur, wr, wc, fr, fq); }
        else E(acc, cur, wr, wc, fr, fq);
        if (!has_next) break;
#pragma unroll
        for (int a = 0; a < 2; ++a)
#pragma unroll
            for (int b = 0; b < 2; ++b)
#pragma unroll
                for (int m = 0; m < 4; ++m)
#pragma unroll
                    for (int n = 0; n < 2; ++n) acc[a][b][m][n] = (f32x4){0.f, 0.f, 0.f, 0.f};
        cur = nxt; cA = nA; cB = nB; ++ui;
    }
    PG8_WAIT_V(0);
    if (wr == 0) PG8_BAR;
    PG8_BAR;
#undef PG8_SA
#undef PG8_SB
#undef PG8_STAGE
#undef PG8_LDA
#undef PG8_LDB
#undef PG8_MMA
#undef PG8_WAIT_V
#undef PG8_WAIT_L
#undef PG8_BAR
#undef PG8_SCHED
}
}

#define XB_TMO      128
#define XB_XCNT(j)  (256  + 64 * (j))
#define XB_XSUB(j)  (1280 + 64 * (j))
#define XB_XGEN(j)  (2304 + 64 * (j))
#define XB_TOP      3328
#define XB_TOPGEN   3392
#define XCD_BAR_WORDS 3456
#define XB_SPIN_CAP (1u << 22)
__device__ __forceinline__ unsigned xb_ld(unsigned* p)              { return __hip_atomic_load(p, __ATOMIC_RELAXED, __HIP_MEMORY_SCOPE_AGENT); }
__device__ __forceinline__ unsigned xb_add(unsigned* p, unsigned v) { return __hip_atomic_fetch_add(p, v, __ATOMIC_RELAXED, __HIP_MEMORY_SCOPE_AGENT); }
__device__ __forceinline__ unsigned xb_xcc_id() { return (unsigned)__builtin_amdgcn_s_getreg((3 << 11) | 20) & 0xFu; }
#define XB_SPIN(cond, bar) do { unsigned _sp = 0; while (cond) { __builtin_amdgcn_s_sleep(1); \
    if ((++_sp & 255u) == 0u) { if (xb_ld(&(bar)[XB_TMO])) break; if (_sp > XB_SPIN_CAP) { atomicAdd(&(bar)[XB_TMO], 1u); break; } } } } while (0)
struct XcdBarrier { unsigned* bar; unsigned x; volatile LAS unsigned* st; };
__device__ __forceinline__ XcdBarrier xcd_barrier_post(unsigned* bar, volatile LAS unsigned* st) {
    XcdBarrier b; b.bar = bar; b.x = xb_xcc_id(); b.st = st;
    if (threadIdx.x == 0) (void)xb_add(&bar[XB_XCNT(b.x)], 1u);
    return b;
}
__device__ __forceinline__ void xcd_barrier_complete(unsigned* bar, unsigned x, unsigned& nloc, unsigned& nx) {
    const unsigned G = gridDim.x * gridDim.y * gridDim.z;
    unsigned sum, cnt, mine, sp = 0u;
    for (;;) {
        sum = 0u; cnt = 0u; mine = 0u;
#pragma unroll
        for (unsigned j = 0; j < 16; ++j) { const unsigned c = xb_ld(&bar[XB_XCNT(j)]); sum += c; cnt += (c > 0u) ? 1u : 0u; mine = (j == x) ? c : mine; }
        if (sum == G) break;
        __builtin_amdgcn_s_sleep(1);
        if ((++sp & 255u) == 0u) { if (xb_ld(&bar[XB_TMO])) break; if (sp > XB_SPIN_CAP) { atomicAdd(&bar[XB_TMO], 1u); break; } }
    }
    nloc = mine > 0u ? mine : 1u; nx = cnt > 0u ? cnt : 1u;
}
template <class F> __device__ __forceinline__ void xcd_barrier(const XcdBarrier& b, F&& side) {
    asm volatile("s_waitcnt vmcnt(0)" ::: "memory");
    __syncthreads();
    if (threadIdx.x >= 64) side();
    if (threadIdx.x == 0) {
        unsigned* bar = b.bar;
        __builtin_amdgcn_s_waitcnt(0);
        unsigned nloc = b.st[0], nx = b.st[1];
        if (nloc == 0u) { xcd_barrier_complete(bar, b.x, nloc, nx); b.st[0] = nloc; b.st[1] = nx; }
        const unsigned old = xb_add(&bar[XB_XSUB(b.x)], 1u);
        const unsigned gen = old / nloc;
        if (old + 1u == (gen + 1u) * nloc) {
            __builtin_amdgcn_fence(__ATOMIC_RELEASE, "agent");
            asm volatile("s_waitcnt vmcnt(0)" ::: "memory");
            const unsigned og = xb_add(&bar[XB_TOP], 1u);
            const unsigned tg = og / nx;
            if (og + 1u == (tg + 1u) * nx) xb_add(&bar[XB_TOPGEN], 1u);
            else XB_SPIN(xb_ld(&bar[XB_TOPGEN]) == tg, bar);
            __builtin_amdgcn_fence(__ATOMIC_ACQUIRE, "agent");
            xb_add(&bar[XB_XGEN(b.x)], 1u);
            asm volatile("s_waitcnt vmcnt(0)" ::: "memory");
        } else {
            XB_SPIN(xb_ld(&bar[XB_XGEN(b.x)]) == gen, bar);
            __builtin_amdgcn_fence(__ATOMIC_ACQUIRE, "agent");
            asm volatile("s_waitcnt vmcnt(0)" ::: "memory");
        }
    }
    __syncthreads();
}
__device__ __forceinline__ void xcd_barrier(const XcdBarrier& b) { xcd_barrier(b, []() {}); }

template <int S> __device__ __forceinline__ float q8e(float x) { return S ? rmb(x) : x; }
template <int S = 0>
__device__ __forceinline__ void transpose_item(const float* __restrict__ W, int N, bf16_t* __restrict__ WT, int ldk, int row_off, LAS float* scr, int item, int lane) {
    const int nblk = N / 32, kb = item / nblk, nb = item % nblk, k0 = 64 * kb, n0 = 32 * nb;
    {
        f32x4 tv[8];
#pragma unroll
        for (int i = 0; i < 8; ++i) tv[i] = __builtin_nontemporal_load((const f32x4*)(W + (size_t)(k0 + 8 * i + (lane >> 3)) * N + n0 + 4 * (lane & 7)));
#pragma unroll
        for (int i = 0; i < 8; ++i) { LAS float* d = scr + (8 * i + (lane >> 3)) * 33 + 4 * (lane & 7); d[0] = tv[i][0]; d[1] = tv[i][1]; d[2] = tv[i][2]; d[3] = tv[i][3]; }
    }
    asm volatile("s_waitcnt lgkmcnt(0)" ::: "memory");
    const int c = lane & 7;
#pragma unroll
    for (int j = 0; j < 4; ++j) { const int n = (lane >> 3) + 8 * j; const LAS float* s = scr + (8 * c) * 33 + n;
        u32x4 o; o.x = cvt_pk_bf16(q8e<S>(s[0 * 33]), q8e<S>(s[1 * 33])); o.y = cvt_pk_bf16(q8e<S>(s[2 * 33]), q8e<S>(s[3 * 33])); o.z = cvt_pk_bf16(q8e<S>(s[4 * 33]), q8e<S>(s[5 * 33])); o.w = cvt_pk_bf16(q8e<S>(s[6 * 33]), q8e<S>(s[7 * 33]));
        *(u32x4*)(WT + (size_t)(row_off + n0 + n) * ldk + k0 + 8 * c) = o; }
    asm volatile("s_waitcnt lgkmcnt(0)" ::: "memory");
}
__device__ __forceinline__ void transpose_item_ln(const float* __restrict__ W, int N, bf16_t* __restrict__ WT, int ldk, const float* __restrict__ gk, const float* __restrict__ bk,
                                                  float* __restrict__ pcs, float* __restrict__ pbw, LAS float* scr, int item, int lane) {
    const int nblk = N / 32, kb = item / nblk, nb = item % nblk, k0 = 64 * kb, n0 = 32 * nb;
    {
        f32x4 tv[8];
#pragma unroll
        for (int i = 0; i < 8; ++i) tv[i] = __builtin_nontemporal_load((const f32x4*)(W + (size_t)(k0 + 8 * i + (lane >> 3)) * N + n0 + 4 * (lane & 7)));
#pragma unroll
        for (int i = 0; i < 8; ++i) { LAS float* d = scr + (8 * i + (lane >> 3)) * 33 + 4 * (lane & 7); d[0] = tv[i][0]; d[1] = tv[i][1]; d[2] = tv[i][2]; d[3] = tv[i][3]; }
    }
    asm volatile("s_waitcnt lgkmcnt(0)" ::: "memory");
    const int c = lane & 7;
    float gv[8], bv[8];
#pragma unroll
    for (int i = 0; i < 8; ++i) { gv[i] = gk[k0 + 8 * c + i]; bv[i] = bk[k0 + 8 * c + i]; }
#pragma unroll
    for (int j = 0; j < 4; ++j) { const int n = (lane >> 3) + 8 * j; const LAS float* s = scr + (8 * c) * 33 + n;
        float w[8]; float sb = 0.f;
#pragma unroll
        for (int i = 0; i < 8; ++i) { const float x = s[i * 33]; sb = fmaf(bv[i], x, sb); w[i] = x * gv[i]; }
        u32x4 o; o.x = cvt_pk_bf16(w[0], w[1]); o.y = cvt_pk_bf16(w[2], w[3]); o.z = cvt_pk_bf16(w[4], w[5]); o.w = cvt_pk_bf16(w[6], w[7]);
        *(u32x4*)(WT + (size_t)(n0 + n) * ldk + k0 + 8 * c) = o;
        float sc = ((__uint_as_float(o.x << 16) + __uint_as_float(o.x & 0xffff0000u)) + (__uint_as_float(o.y << 16) + __uint_as_float(o.y & 0xffff0000u)))
                 + ((__uint_as_float(o.z << 16) + __uint_as_float(o.z & 0xffff0000u)) + (__uint_as_float(o.w << 16) + __uint_as_float(o.w & 0xffff0000u)));
        sc += __shfl_xor(sc, 1); sc += __shfl_xor(sc, 2); sc += __shfl_xor(sc, 4);
        sb += __shfl_xor(sb, 1); sb += __shfl_xor(sb, 2); sb += __shfl_xor(sb, 4);
        if (c == 0) { pcs[(size_t)kb * N + n0 + n] = sc; pbw[(size_t)kb * N + n0 + n] = sb; } }
    asm volatile("s_waitcnt lgkmcnt(0)" ::: "memory");
}

struct Params {
    const float *x, *w_in, *conv_w, *a_log, *dt_bias, *dn_norm_w, *attn_sink, *rel_bias, *w_out, *ln1_g, *ln1_b, *peer_wq, *peer_keys, *peer_u, *peer_v, *ln2_g, *ln2_b;
    float* out;
    bf16_t *R, *WOUTT, *WQT;
    bf16_t *AQ, *AK, *AVT, *DQ, *DK, *DV, *DZ; float* BG;
    bf16_t *MIX, *HB, *QP;
    float *PART, *PCS, *PBW, *CS, *BW, *GATE, *US, *VS;
    bf16_t* PREB;
    unsigned char *U8, *V8;
    unsigned* BAR;
    unsigned* FLAG;
    bf16_t *OF, *OB;
    unsigned char *DNS, *DND;
    int* EIDX;
};

__device__ __forceinline__ void phase_prep(const Params& p, LAS unsigned char* lds) {
    int tid_ = threadIdx.x; asm volatile("" : "+v"(tid_) :: "memory");
    const int tid = tid_, wave = tid >> 6, lane = tid & 63, G = gridDim.x;
    {
        const size_t n8 = (size_t)T * D / 8, stride = (size_t)G * NTHREADS;
        for (size_t i = (size_t)blockIdx.x * NTHREADS + tid; i < n8; i += 4 * stride) {
            f32x4 a[4], b[4];
#pragma unroll
            for (int u = 0; u < 4; ++u) { const size_t q = i + u * stride < n8 ? i + u * stride : i; a[u] = __builtin_nontemporal_load((const f32x4*)(p.x + q * 8)); b[u] = __builtin_nontemporal_load((const f32x4*)(p.x + q * 8 + 4)); }
#pragma unroll
            for (int u = 0; u < 4; ++u) {
                u32x4 o; o.x = cvt_pk_bf16(q8e<1>(a[u][0]), q8e<1>(a[u][1])); o.y = cvt_pk_bf16(q8e<1>(a[u][2]), q8e<1>(a[u][3])); o.z = cvt_pk_bf16(q8e<1>(b[u][0]), q8e<1>(b[u][1])); o.w = cvt_pk_bf16(q8e<1>(b[u][2]), q8e<1>(b[u][3]));
                if (i + u * stride < n8) *(u32x4*)(p.R + (i + u * stride) * 8) = o;
            }
        }
    }
    {
        const size_t n16 = (size_t)(5888 - INW) * D * 2 / 16;
        u32x4* z = (u32x4*)(p.R + (size_t)(T + INW) * D);
        for (size_t i = (size_t)blockIdx.x * NTHREADS + tid; i < n16; i += (size_t)G * NTHREADS) z[i] = (u32x4){0u, 0u, 0u, 0u};
    }
    LAS float* scr = (LAS float*)(lds + wave * 8704);
    const int gw = blockIdx.x * 8 + wave, NGW = G * 8;
    constexpr int I_IN = (D / 64) * (INW / 32);
    for (int it = gw; it < I_IN; it += NGW) transpose_item<32>(p.w_in, INW, p.R, D, T, scr, it, lane);
}
__device__ __forceinline__ void phase_prep_late(const Params& p, LAS unsigned char* lds, int bidx, int nblk) {
    int tid_ = threadIdx.x; asm volatile("" : "+v"(tid_) :: "memory");
    const int wave = tid_ >> 6, lane = tid_ & 63;
    LAS float* scr = (LAS float*)(lds + wave * 8704);
    constexpr int I_SQ = (D / 64) * (D / 32);
    for (int it = bidx * 8 + wave; it < 2 * I_SQ; it += nblk * 8) {
        if (it < I_SQ) transpose_item(p.w_out, D, p.WOUTT, D, 0, scr, it, lane);
        else transpose_item_ln(p.peer_wq, D, p.WQT, D, p.ln1_g, p.ln1_b, p.PCS, p.PBW, scr, it - I_SQ, lane);
    }
}

__device__ __forceinline__ void ln_body(int vb, int tid, char* sm, const float* __restrict__ X, const float* __restrict__ g, const float* __restrict__ bta, float* __restrict__ Y, bf16_t* __restrict__ Yb) {
    float* red = (float*)sm;
    const int t = vb;
    __syncthreads();
    const float4* xr = (const float4*)(X + (size_t)t * 2048);
    const float4 a = xr[tid], c = xr[tid + 256];
    float s = (a.x + a.y) + (a.z + a.w) + (c.x + c.y) + (c.z + c.w);
    s = wave_sum(s);
    if ((tid & 63) == 0) red[tid >> 6] = s;
    __syncthreads();
    const float mean = (red[0] + red[1] + red[2] + red[3]) * (1.0f / 2048.0f);
    __syncthreads();
    const float d0 = a.x - mean, d1 = a.y - mean, d2 = a.z - mean, d3 = a.w - mean, d4 = c.x - mean, d5 = c.y - mean, d6 = c.z - mean, d7 = c.w - mean;
    float q = d0 * d0 + d1 * d1 + d2 * d2 + d3 * d3 + d4 * d4 + d5 * d5 + d6 * d6 + d7 * d7;
    q = wave_sum(q);
    if ((tid & 63) == 0) red[tid >> 6] = q;
    __syncthreads();
    const float rstd = 1.0f / sqrtf((red[0] + red[1] + red[2] + red[3]) * (1.0f / 2048.0f) + LN_EPS);
    const float4 g0 = ((const float4*)g)[tid], g1 = ((const float4*)g)[tid + 256], b0 = ((const float4*)bta)[tid], b1 = ((const float4*)bta)[tid + 256];
    float4 o0, o1;
    o0.x = d0 * rstd * g0.x + b0.x; o0.y = d1 * rstd * g0.y + b0.y; o0.z = d2 * rstd * g0.z + b0.z; o0.w = d3 * rstd * g0.w + b0.w;
    o1.x = d4 * rstd * g1.x + b1.x; o1.y = d5 * rstd * g1.y + b1.y; o1.z = d6 * rstd * g1.z + b1.z; o1.w = d7 * rstd * g1.w + b1.w;
    float4* yr = (float4*)(Y + (size_t)t * 2048);
    yr[tid] = o0; yr[tid + 256] = o1;
    u32x2 w0, w1; w0.x = cvt_pk_bf16(o0.x, o0.y); w0.y = cvt_pk_bf16(o0.z, o0.w); w1.x = cvt_pk_bf16(o1.x, o1.y); w1.y = cvt_pk_bf16(o1.z, o1.w);
    u32x2* ybr = (u32x2*)(Yb + (size_t)t * 2048);
    ybr[tid] = w0; ybr[tid + 256] = w1;
}

__device__ __forceinline__ void wave_argmax(float& v, int& i) {
#pragma unroll
    for (int o = 1; o < 64; o <<= 1) {
        const float ov = __shfl_xor(v, o); const int oi = __shfl_xor(i, o);
        if (ov > v || (ov == v && oi < i)) { v = ov; i = oi; }
    }
}
template <class TQ>
__device__ __forceinline__ void select_body(int vb, int tid, char* sm, const TQ* __restrict__ Q, const float* __restrict__ keys, int* __restrict__ eidx, float* __restrict__ gate) {
    float (*qs)[256] = (float (*)[256])sm;
    float (*svs)[2][16] = (float (*)[2][16])(sm + 4096);
    int (*sis)[2][16] = (int (*)[2][16])(sm + 4096 + 512);
    const int wave = tid >> 6, lane = tid & 63;
    const int item = vb * 4 + wave, hd = item & 7, t = item >> 3;
    __syncthreads();
    const TQ* qrow = Q + (size_t)t * 2048 + hd * 256;
#pragma unroll
    for (int j = 0; j < 4; ++j) qs[wave][lane + 64 * j] = ldf(qrow + lane + 64 * j);
    __syncthreads();
    float sc[2][2];
#pragma unroll
    for (int pp = 0; pp < 2; ++pp)
#pragma unroll
        for (int kk = 0; kk < 2; ++kk) {
            const float4* kr = (const float4*)(keys + ((size_t)pp * 128 + lane + 64 * kk) * 128);
            float d = 0.f;
#pragma unroll 2
            for (int c = 0; c < 32; ++c) { const float4 kv = kr[c]; const float4 qv = *(const float4*)&qs[wave][pp * 128 + c * 4]; d += qv.x * kv.x + qv.y * kv.y + qv.z * kv.z + qv.w * kv.w; }
            sc[pp][kk] = d;
        }
#pragma unroll
    for (int pp = 0; pp < 2; ++pp) {
        for (int r = 0; r < 16; ++r) {
            float v; int i;
            if (sc[pp][0] >= sc[pp][1]) { v = sc[pp][0]; i = lane; } else { v = sc[pp][1]; i = lane + 64; }
            wave_argmax(v, i);
            if (lane == 0) { svs[wave][pp][r] = v; sis[wave][pp][r] = i; }
            if (i == lane) sc[pp][0] = -INFINITY;
            if (i == lane + 64) sc[pp][1] = -INFINITY;
        }
    }
    __syncthreads();
    float cs[4];
#pragma unroll
    for (int j = 0; j < 4; ++j) { const int c = lane + 64 * j; cs[j] = svs[wave][0][c >> 4] + svs[wave][1][c & 15]; }
    float tops = 0.f; int topc = 0;
    for (int r = 0; r < 16; ++r) {
        float v = cs[0]; int i = lane;
#pragma unroll
        for (int j = 1; j < 4; ++j) if (cs[j] > v) { v = cs[j]; i = lane + 64 * j; }
        wave_argmax(v, i);
        if (lane == r) { tops = v; topc = i; }
#pragma unroll
        for (int j = 0; j < 4; ++j) if (i == lane + 64 * j) cs[j] = -INFINITY;
    }
    float m = (lane < 16) ? tops : -INFINITY;
    m = wave_max(m);
    const float e = (lane < 16) ? expf(tops - m) : 0.f;
    const float den = wave_sum(e);
    if (lane < 16) {
        const int ex = sis[wave][0][topc >> 4] * 128 + sis[wave][1][topc & 15];
        eidx[(size_t)t * 128 + hd * 16 + lane] = ex;
        gate[(size_t)t * 128 + hd * 16 + lane] = e / den;
    }
}

__device__ __forceinline__ void gather_body(int vb, int tid, const float* __restrict__ H, const int* __restrict__ eidx, const float* __restrict__ gate, const float* __restrict__ U, const float* __restrict__ V,
                                            const float* __restrict__ g2, const float* __restrict__ b2, float* __restrict__ out) {
    const int wave = tid >> 6, lane = tid & 63;
    const int t = vb * 4 + wave;
    const float4* hr = (const float4*)(H + (size_t)t * 2048);
    float4 hv[8], acc[8];
#pragma unroll
    for (int j = 0; j < 8; ++j) { hv[j] = hr[lane + 64 * j]; acc[j] = make_float4(0.f, 0.f, 0.f, 0.f); }
    for (int pp = 0; pp < 128; ++pp) {
        const int e = eidx[(size_t)t * 128 + pp];
        const float gt = gate[(size_t)t * 128 + pp];
        const float4* ur = (const float4*)(U + (size_t)e * 2048);
        float d = 0.f;
#pragma unroll
        for (int j = 0; j < 8; ++j) { const float4 u = ur[lane + 64 * j]; d += u.x * hv[j].x + u.y * hv[j].y + u.z * hv[j].z + u.w * hv[j].w; }
        d = wave_sum(d);
        const float act = 0.5f * d * (1.0f + erff(d * 0.7071067811865476f));
        const float cf = act * gt;
        const float4* vr = (const float4*)(V + (size_t)e * 2048);
#pragma unroll
        for (int j = 0; j < 8; ++j) { const float4 vv = vr[lane + 64 * j]; acc[j].x += cf * vv.x; acc[j].y += cf * vv.y; acc[j].z += cf * vv.z; acc[j].w += cf * vv.w; }
    }
    float s = 0.f;
#pragma unroll
    for (int j = 0; j < 8; ++j) { acc[j].x += ALPHA * hv[j].x; acc[j].y += ALPHA * hv[j].y; acc[j].z += ALPHA * hv[j].z; acc[j].w += ALPHA * hv[j].w; s += (acc[j].x + acc[j].y) + (acc[j].z + acc[j].w); }
    const float mean = wave_sum(s) * (1.0f / 2048.0f);
    float q = 0.f;
#pragma unroll
    for (int j = 0; j < 8; ++j) { acc[j].x -= mean; acc[j].y -= mean; acc[j].z -= mean; acc[j].w -= mean; q += acc[j].x * acc[j].x + acc[j].y * acc[j].y + acc[j].z * acc[j].z + acc[j].w * acc[j].w; }
    const float rstd = 1.0f / sqrtf(wave_sum(q) * (1.0f / 2048.0f) + LN_EPS);
    float4* orow = (float4*)(out + (size_t)t * 2048);
#pragma unroll
    for (int j = 0; j < 8; ++j) {
        const float4 g = ((const float4*)g2)[lane + 64 * j], bb = ((const float4*)b2)[lane + 64 * j];
        float4 o; o.x = acc[j].x * rstd * g.x + bb.x; o.y = acc[j].y * rstd * g.y + bb.y; o.z = acc[j].z * rstd * g.z + bb.z; o.w = acc[j].w * rstd * g.w + bb.w;
        orow[lane + 64 * j] = o;
    }
}

constexpr int DNS_QN = 0, DNS_KNT = 16384, DNS_SIZE = 32768;
constexpr int DND_WN = 0, DND_UT = 16384, DND_AM = 32768, DND_EG = 40960, DND_EGL = 41216, DND_GL = 41472, DND_SIZE = 41984;

__device__ __forceinline__ f32x4 mfma16(bf16x8 a, bf16x8 b, f32x4 c) { return __builtin_amdgcn_mfma_f32_16x16x32_bf16(a, b, c, 0, 0, 0); }
template <int CTRL> __device__ __forceinline__ float dpp_mov(float v) { return __int_as_float(__builtin_amdgcn_update_dpp(0, __float_as_int(v), CTRL, 0xF, 0xF, true)); }
__device__ __forceinline__ float quad_sum(float v) { v += dpp_mov<0xB1>(v); v += dpp_mov<0x4E>(v); return v; }
__device__ __forceinline__ float row16_sum(float v) { v = quad_sum(v); v += dpp_mov<0x141>(v); v += dpp_mov<0x140>(v); return v; }

template <int MODE> __device__ __forceinline__ void gst64(void* ptr, u32x2 v) {
    if (MODE) __hip_atomic_store((unsigned long long*)ptr, ((unsigned long long)v.y << 32) | (unsigned long long)v.x, __ATOMIC_RELAXED, __HIP_MEMORY_SCOPE_AGENT);
    else *(u32x2*)ptr = v;
}
__device__ __forceinline__ void st16_wt(__amdgpu_buffer_rsrc_t rs, unsigned off, u32x4 v) { __builtin_amdgcn_raw_buffer_store_b128(v, rs, (int)off, 0,   16); }
template <int MODE> __device__ __forceinline__ void gst128(void* ptr, __amdgpu_buffer_rsrc_t rs, unsigned off, u32x4 v) {
    if (MODE) st16_wt(rs, off, v);
    else *(u32x4*)ptr = v;
}
template <int MODE> __device__ __forceinline__ void gst32(float* ptr, float v) {
    if (MODE) __hip_atomic_store(ptr, v, __ATOMIC_RELAXED, __HIP_MEMORY_SCOPE_AGENT);
    else *ptr = v;
}
constexpr int DN_LEVEL0 = 16;
template <int MODE>
__device__ __forceinline__ void phase_dnprep(const Params& p, LAS unsigned char* lds) {
    constexpr int L_QN = 0, L_KN = 17408;
    constexpr int L_KT = 34816, L_VT = L_KT + 18432;
    constexpr int L_T = L_VT + 18432;
    constexpr int L_CW = L_T + 4 * 9216;
    constexpr int L_SM = L_CW + 7680;
    int tid_ = threadIdx.x; asm volatile("" : "+v"(tid_) :: "memory");
    LAS float* convw = (LAS float*)(lds + L_CW);
    LAS float* betas = (LAS float*)(lds + L_SM);
    LAS float* Gs = betas + 128;
    const __amdgpu_buffer_rsrc_t rs_dns = __builtin_amdgcn_make_buffer_rsrc(p.DNS, (short)0, 2048 * DNS_SIZE, 0x00020000);
    const __amdgpu_buffer_rsrc_t rs_dnd = __builtin_amdgcn_make_buffer_rsrc(p.DND, (short)0, 2048 * 2 * DND_SIZE, 0x00020000);
    int prev_h = -1;
    int prev_it = -1;
#pragma unroll 1
    for (int ii = 0; ; ++ii) {
        const int nn = MODE != 1 ? (int)blockIdx.x + (int)gridDim.x * ii : 64 * DN_LEVEL0 + ((int)gridDim.x - 64) * ii + ((int)blockIdx.x - 64);
        if (nn >= (MODE != 1 ? 64 * DN_LEVEL0 : 2048)) break;
        const int it = (nn & 31) * 64 + ((nn & 32) ? 63 - (nn >> 6) : (nn >> 6));
        asm volatile("" : "+v"(tid_) :: "memory");
        const int tid = tid_, wave = tid >> 6, lane = tid & 63, n16 = lane & 15, g = lane >> 4;
        const int c = it & 63, bh = it >> 6, h = bh & 7, b = bh >> 3;
        const size_t t0 = (size_t)b * S + c * 64;
        unsigned char* srec = p.DNS + (size_t)it * DNS_SIZE;
        unsigned char* drec0 = p.DND + (size_t)it * 2 * DND_SIZE;
        const unsigned soff = (unsigned)it * DNS_SIZE, doff = (unsigned)it * 2u * DND_SIZE;
        const int tg = tid >> 4, cg = tid & 15;
        u32x4 raw[3][6];
#define DN_LOAD_RAW(tensor) { \
            const bf16_t* base = ((tensor) == 0 ? p.DQ : ((tensor) == 1 ? p.DK : p.DV)) + (size_t)b * S * 1024 + h * 128 + 8 * cg; \
            _Pragma("unroll") for (int jj = 0; jj < 6; ++jj) { const int sj = c * 64 + 2 * tg + jj - 2; const bool ok = (sj >= 0 && sj < S); \
                const u32x4 ld = *(const u32x4*)(base + (size_t)(ok ? sj : 0) * 1024); raw[tensor][jj] = ok ? ld : (u32x4){0u, 0u, 0u, 0u}; } }
        DN_LOAD_RAW(0) DN_LOAD_RAW(1) DN_LOAD_RAW(2)
#undef DN_LOAD_RAW
        if (h != prev_h) {
            for (int i = tid; i < 1920; i += NTHREADS) { const int tensor = i / 640, rem = i % 640, j = rem >> 7, ch = rem & 127; convw[i] = p.conv_w[j * 3072 + tensor * 1024 + h * 128 + ch]; }
            prev_h = h;
        }
        if (tid < 128) {
            const int dir = tid >> 6, r = tid & 63;
            const float braw = p.BG[(t0 + r) * 32 + dir * 8 + h], araw = p.BG[(t0 + r) * 32 + 16 + dir * 8 + h];
            const float beta = sigmoid_f(braw);
            const float gg = -expf(p.a_log[dir * 8 + h]) * softplus_f(araw + p.dt_bias[dir * 8 + h]);
            float Gc = gg;
#pragma unroll
            for (int o = 1; o < 64; o <<= 1) { const float up = __shfl_up(Gc, o), dn = __shfl_down(Gc, o); if (dir == 0) { if (r >= o) Gc += up; } else { if (r + o < 64) Gc += dn; } }
            const float Glast = __shfl(Gc, dir ? 0 : 63);
            betas[dir * 64 + r] = beta; Gs[dir * 64 + r] = Gc * 1.4426950408889634f;
            float* eg = (float*)(drec0 + (size_t)dir * DND_SIZE + DND_EG);
            gst32<MODE>(eg + r, expf(Gc)); gst32<MODE>(eg + 64 + r, expf(Glast - Gc));
            if (r == 0) gst32<MODE>(eg + 128, expf(Glast));
        }
        if (MODE) asm volatile("s_waitcnt vmcnt(0)" ::: "memory");
        __syncthreads();
        if (MODE && threadIdx.x == 0 && prev_it >= 0) (void)xb_add(&p.FLAG[prev_it], 1u);
        {
            const int r0 = 2 * tg;
            const int tro = (((r0 >> 3) ^ (cg & 7)) << 4) + (r0 & 7) * 2;
#pragma unroll
            for (int tensor = 0; tensor < 3; ++tensor) {
                float a[2][8];
#pragma unroll
                for (int i = 0; i < 8; ++i) { a[0][i] = 0.f; a[1][i] = 0.f; }
                f32x4 wp0 = (f32x4){0.f, 0.f, 0.f, 0.f}, wp1 = wp0;
#pragma unroll
                for (int jj = 0; jj < 6; ++jj) {
                    const u32x4 rw = raw[tensor][jj];
                    const float x[8] = {__uint_as_float(rw.x << 16), __uint_as_float(rw.x & 0xffff0000u), __uint_as_float(rw.y << 16), __uint_as_float(rw.y & 0xffff0000u),
                                        __uint_as_float(rw.z << 16), __uint_as_float(rw.z & 0xffff0000u), __uint_as_float(rw.w << 16), __uint_as_float(rw.w & 0xffff0000u)};
                    if (jj >= 1) {
#pragma unroll
                        for (int i = 0; i < 8; ++i) a[1][i] = fmaf(i < 4 ? wp0[i] : wp1[i - 4], x[i], a[1][i]);
                    }
                    if (jj < 5) {
                        const f32x4 w0 = *(const LAS f32x4*)(convw + tensor * 640 + jj * 128 + 8 * cg), w1 = *(const LAS f32x4*)(convw + tensor * 640 + jj * 128 + 8 * cg + 4);
#pragma unroll
                        for (int i = 0; i < 8; ++i) a[0][i] = fmaf(i < 4 ? w0[i] : w1[i - 4], x[i], a[0][i]);
                        wp0 = w0; wp1 = w1;
                    }
                }
                float y[2][8];
#pragma unroll
                for (int tok = 0; tok < 2; ++tok) {
                    const int r = r0 + tok;
                    float ss = 0.f;
#pragma unroll
                    for (int i = 0; i < 8; ++i) { y[tok][i] = silu_f(a[tok][i]); ss = fmaf(y[tok][i], y[tok][i], ss); }
                    if (tensor < 2) {
                        ss = row16_sum(ss);
                        const float rn = __builtin_amdgcn_rsqf(ss + RMS_EPS) * (tensor == 0 ? 0.08838834764831845f : 1.0f);
#pragma unroll
                        for (int i = 0; i < 8; ++i) y[tok][i] *= rn;
                        u32x4 pv; pv.x = cvt_pk_bf16(y[tok][0], y[tok][1]); pv.y = cvt_pk_bf16(y[tok][2], y[tok][3]); pv.z = cvt_pk_bf16(y[tok][4], y[tok][5]); pv.w = cvt_pk_bf16(y[tok][6], y[tok][7]);
                        *(LAS u32x4*)(lds + (tensor == 0 ? L_QN : L_KN) + r * 272 + cg * 16) = pv;
                        if (tensor == 0) gst128<MODE>(srec + DNS_QN + r * 256 + cg * 16, rs_dns, soff + DNS_QN + r * 256 + cg * 16, pv);
                    }
                }
                if (tensor >= 1) {
#pragma unroll
                    for (int i = 0; i < 8; ++i) *(LAS unsigned*)(lds + (tensor == 1 ? L_KT : L_VT) + (8 * cg + i) * 144 + tro) = cvt_pk_bf16(y[0][i], y[1][i]);
                }
            }
        }
        __syncthreads();
        {
#pragma unroll
            for (int i = 0; i < 2; ++i) { const int q = tid + NTHREADS * i, row = q >> 3, c8 = q & 7;
                gst128<MODE>(srec + DNS_KNT + row * 128 + c8 * 16, rs_dns, soff + DNS_KNT + row * 128 + c8 * 16, *(const LAS u32x4*)(lds + L_KT + row * 144 + ((c8 ^ ((row >> 3) & 7)) << 4))); }
        }
        f32x4 kk2[2], qk2[2];
#pragma unroll
        for (int jb = 0; jb < 2; ++jb) {
            const int job = wave * 2 + jb, ta = job >> 2, tb = job & 3;
            f32x4 ak = (f32x4){0.f, 0.f, 0.f, 0.f}, aq = (f32x4){0.f, 0.f, 0.f, 0.f};
#pragma unroll
            for (int ks = 0; ks < 4; ++ks) {
                const bf16x8 ka = *(const LAS bf16x8*)(lds + L_KN + (16 * ta + n16) * 272 + ks * 64 + g * 16);
                const bf16x8 kb = *(const LAS bf16x8*)(lds + L_KN + (16 * tb + n16) * 272 + ks * 64 + g * 16);
                const bf16x8 qb = *(const LAS bf16x8*)(lds + L_QN + (16 * tb + n16) * 272 + ks * 64 + g * 16);
                ak = mfma16(ka, kb, ak);
                aq = mfma16(ka, qb, aq);
            }
            kk2[jb] = ak; qk2[jb] = aq;
        }
        __syncthreads();
#pragma unroll
        for (int jb = 0; jb < 2; ++jb) {
            const int job = wave * 2 + jb, ta = job >> 2, tb = job & 3;
            {
                const int j = 16 * tb + n16;
                const float G0j = Gs[j], G1j = Gs[64 + j];
#pragma unroll
                for (int rr = 0; rr < 4; ++rr) {
                    const int i = 16 * ta + 4 * g + rr;
                    const float kkv = kk2[jb][rr];
                    const float l0 = (j < i) ? betas[i] * kkv * __builtin_amdgcn_exp2f(Gs[i] - G0j) : 0.f;
                    const float l1 = (j > i) ? betas[64 + i] * kkv * __builtin_amdgcn_exp2f(Gs[64 + i] - G1j) : 0.f;
                    *(LAS float*)(lds + L_QN + (i * 64 + (j & 3) * 16 + (j >> 2)) * 4) = l0;
                    const int ir = 63 - i, jr = 63 - j;
                    *(LAS float*)(lds + L_KN + (ir * 64 + (jr & 3) * 16 + (jr >> 2)) * 4) = l1;
                }
            }
            {
                const int i = 16 * tb + n16;
                const float G0i = Gs[i], G1i = Gs[64 + i];
                float a0[4], a1[4];
#pragma unroll
                for (int rr = 0; rr < 4; ++rr) {
                    const int j = 16 * ta + 4 * g + rr;
                    const float qkv = qk2[jb][rr];
                    a0[rr] = (j <= i) ? qkv * __builtin_amdgcn_exp2f(G0i - Gs[j]) : 0.f;
                    a1[rr] = (j >= i) ? qkv * __builtin_amdgcn_exp2f(G1i - Gs[64 + j]) : 0.f;
                }
                u32x2 w0, w1; w0.x = cvt_pk_bf16(a0[0], a0[1]); w0.y = cvt_pk_bf16(a0[2], a0[3]); w1.x = cvt_pk_bf16(a1[0], a1[1]); w1.y = cvt_pk_bf16(a1[2], a1[3]);
                if constexpr (MODE) {
                    const int pos = i * 128 + (((2 * ta + (g >> 1)) ^ (i & 7)) << 4) + (g & 1) * 8;
                    *(LAS u32x2*)(lds + L_T + pos) = w0; *(LAS u32x2*)(lds + L_T + 8192 + pos) = w1;
                } else {
                    gst64<MODE>(drec0 + DND_AM + (i * 64 + 16 * ta + 4 * g) * 2, w0);
                    gst64<MODE>(drec0 + DND_SIZE + DND_AM + (i * 64 + 16 * ta + 4 * g) * 2, w1);
                }
            }
        }
        __syncthreads();
        if constexpr (MODE) {
#pragma unroll
            for (int u = 0; u < 2; ++u) { const int q = tid + NTHREADS * u, dd = q >> 9, qq = q & 511, row = qq >> 3, c8 = qq & 7;
                st16_wt(rs_dnd, doff + dd * DND_SIZE + DND_AM + qq * 16, *(const LAS u32x4*)(lds + L_T + dd * 8192 + row * 128 + ((c8 ^ (row & 7)) << 4))); }
            __syncthreads();
        }
        {
            const int dir = wave >> 2, cb = __builtin_amdgcn_readfirstlane(dir ? 3 - (wave & 3) : (wave & 3)), nblk = 4 - cb, cl = lane >> 2, q = lane & 3;
            const LAS float* Lq = (const LAS float*)(lds + (dir ? L_KN : L_QN)) + q * 16 + (16 * cb) * 64 + 4 * cb;
            float Tq[16];
#pragma unroll
            for (int m = 0; m < 16; ++m) Tq[m] = 0.f;
            f32x4 lv[2][4];
            lv[0][0] = *(const LAS f32x4*)(Lq);
#define S3_STEPS(LO) _Pragma("unroll") for (int i = (LO); i < (LO) + 16; ++i) { \
                const int mi = i >> 2, qi = i & 3; \
                if (i < 63) { _Pragma("unroll") for (int mm = 0; mm <= ((i + 1) >> 4); ++mm) lv[(i + 1) & 1][mm] = *(const LAS f32x4*)(Lq + (i + 1) * 64 + 4 * mm); } \
                float acc0 = 0.f, acc1 = 0.f; \
                _Pragma("unroll") for (int mm = 0; mm <= (mi >> 2); ++mm) { \
                    const f32x4 l4 = lv[i & 1][mm]; \
                    acc0 = fmaf(l4[0], Tq[4 * mm], acc0); acc1 = fmaf(l4[1], Tq[4 * mm + 1], acc1); \
                    acc0 = fmaf(l4[2], Tq[4 * mm + 2], acc0); acc1 = fmaf(l4[3], Tq[4 * mm + 3], acc1); } \
                const float tot = quad_sum(acc0 + acc1); \
                const float val = ((cl == i) ? 1.0f : 0.0f) - tot; \
                Tq[mi] = (q == qi) ? val : Tq[mi]; }
            S3_STEPS(0)
            if (nblk > 1) { S3_STEPS(16)
                if (nblk > 2) { S3_STEPS(32)
                    if (nblk > 3) { S3_STEPS(48) } } }
#undef S3_STEPS
            const int cidx = 16 * cb + cl;
            const int col = dir ? (63 - cidx) : cidx;
            const float bc = betas[dir * 64 + col], bgc = bc * __builtin_amdgcn_exp2f(Gs[dir * 64 + col]);
#pragma unroll
            for (int m = 0; m < 16; ++m) {
                if (m < 4 * nblk) {
                    const int i = 16 * cb + 4 * m + q;
                    const int row = dir ? (63 - i) : i;
                    *(LAS bf16_t*)(lds + L_T + dir * 9216 + row * 144 + col * 2) = f2bf(Tq[m] * bc);
                    *(LAS bf16_t*)(lds + L_T + (2 + dir) * 9216 + row * 144 + col * 2) = f2bf(Tq[m] * bgc);
                } else {
                    const int i = 4 * (m - 4 * nblk) + q;
                    const int row = dir ? (63 - i) : i;
                    *(LAS bf16_t*)(lds + L_T + dir * 9216 + row * 144 + col * 2) = (bf16_t)0;
                    *(LAS bf16_t*)(lds + L_T + (2 + dir) * 9216 + row * 144 + col * 2) = (bf16_t)0;
                }
            }
        }
        __syncthreads();
        if constexpr (MODE == 0) {
#pragma unroll 4
        for (int jj = 0; jj < 16; ++jj) {
            const int job = wave * 16 + jj, dir = job >> 6, kind = (job >> 5) & 1, tl = job & 31;
            const LAS unsigned char* Tb = lds + L_T + (2 * kind + dir) * 9216;
            unsigned char* drec = drec0 + (size_t)dir * DND_SIZE;
            f32x4 acc = (f32x4){0.f, 0.f, 0.f, 0.f};
            if (kind == 0) {
                const int itl = tl >> 3, ct = tl & 7, ch = 16 * ct + n16;
                const LAS unsigned char* Vb = lds + L_VT + ch * 144;
#pragma unroll
                for (int ks = 0; ks < 2; ++ks) {
                    const bf16x8 a = *(const LAS bf16x8*)(Tb + (16 * itl + n16) * 144 + ks * 64 + g * 16);
                    const bf16x8 bb = *(const LAS bf16x8*)(Vb + (((4 * ks + g) ^ ((ch >> 3) & 7)) << 4));
                    acc = mfma16(a, bb, acc);
                }
                u32x2 w; w.x = cvt_pk_bf16(acc[0], acc[1]); w.y = cvt_pk_bf16(acc[2], acc[3]);
                gst64<MODE>(drec + DND_UT + (ch * 64 + 16 * itl + 4 * g) * 2, w);
            } else {
                const int dt = tl >> 2, itl = tl & 3, dk = 16 * dt + n16;
                const LAS unsigned char* Kb = lds + L_KT + dk * 144;
#pragma unroll
                for (int ks = 0; ks < 2; ++ks) {
                    const bf16x8 a = *(const LAS bf16x8*)(Kb + (((4 * ks + g) ^ ((dk >> 3) & 7)) << 4));
                    const bf16x8 bb = *(const LAS bf16x8*)(Tb + (16 * itl + n16) * 144 + ks * 64 + g * 16);
                    acc = mfma16(a, bb, acc);
                }
                u32x2 w; w.x = cvt_pk_bf16(-acc[0], -acc[1]); w.y = cvt_pk_bf16(-acc[2], -acc[3]);
                gst64<MODE>(drec + DND_WN + ((16 * itl + n16) * 128 + 16 * dt + 4 * g) * 2, w);
            }
        }
        } else {
#pragma unroll 1
            for (int dir = 0; dir < 2; ++dir) {
#pragma unroll 4
                for (int jj = 0; jj < 8; ++jj) {
                    const int j8 = wave * 8 + jj, kind = (j8 >> 5) & 1, tl = j8 & 31;
                    const LAS unsigned char* Tb = lds + L_T + (2 * kind + dir) * 9216;
                    f32x4 acc = (f32x4){0.f, 0.f, 0.f, 0.f};
                    if (kind == 0) {
                        const int itl = tl >> 3, ct = tl & 7, ch = 16 * ct + n16;
                        const LAS unsigned char* Vb = lds + L_VT + ch * 144;
#pragma unroll
                        for (int ks = 0; ks < 2; ++ks) {
                            const bf16x8 a = *(const LAS bf16x8*)(Tb + (16 * itl + n16) * 144 + ks * 64 + g * 16);
                            const bf16x8 bb = *(const LAS bf16x8*)(Vb + (((4 * ks + g) ^ ((ch >> 3) & 7)) << 4));
                            acc = mfma16(a, bb, acc);
                        }
                        u32x2 w; w.x = cvt_pk_bf16(acc[0], acc[1]); w.y = cvt_pk_bf16(acc[2], acc[3]);
                        *(LAS u32x2*)(lds + L_QN + ch * 128 + (((2 * itl + (g >> 1)) ^ (ch & 7)) << 4) + (g & 1) * 8) = w;
                    } else {
                        const int dt = tl >> 2, itl = tl & 3, dk = 16 * dt + n16, i = 16 * itl + n16;
                        const LAS unsigned char* Kb = lds + L_KT + dk * 144;
#pragma unroll
                        for (int ks = 0; ks < 2; ++ks) {
                            const bf16x8 a = *(const LAS bf16x8*)(Kb + (((4 * ks + g) ^ ((dk >> 3) & 7)) << 4));
                            const bf16x8 bb = *(const LAS bf16x8*)(Tb + (16 * itl + n16) * 144 + ks * 64 + g * 16);
                            acc = mfma16(a, bb, acc);
                        }
                        u32x2 w; w.x = cvt_pk_bf16(-acc[0], -acc[1]); w.y = cvt_pk_bf16(-acc[2], -acc[3]);
                        *(LAS u32x2*)(lds + L_QN + 16384 + i * 256 + (((2 * dt + (g >> 1)) ^ (i & 15)) << 4) + (g & 1) * 8) = w;
                    }
                }
                __syncthreads();
#pragma unroll
                for (int u = 0; u < 4; ++u) {
                    const int q = tid + NTHREADS * u;
                    if (q < 1024) { const int row = q >> 3, c8 = q & 7;
                        st16_wt(rs_dnd, doff + dir * DND_SIZE + DND_UT + q * 16, *(const LAS u32x4*)(lds + L_QN + row * 128 + ((c8 ^ (row & 7)) << 4))); }
                    else { const int q2 = q - 1024, row = q2 >> 4, c16 = q2 & 15;
                        st16_wt(rs_dnd, doff + dir * DND_SIZE + DND_WN + q2 * 16, *(const LAS u32x4*)(lds + L_QN + 16384 + row * 256 + ((c16 ^ (row & 15)) << 4))); }
                }
                if (dir == 0) __syncthreads();
            }
        }
        __syncthreads();
        prev_it = it;
    }
    if (MODE) {
        asm volatile("s_waitcnt vmcnt(0)" ::: "memory");
        __syncthreads();
        if (threadIdx.x == 0 && prev_it >= 0) (void)xb_add(&p.FLAG[prev_it], 1u);
    }
}

template <int DIR>
__device__ __forceinline__ void phase_dnscan(const Params& p, LAS unsigned char* lds) {
    constexpr int B_WN = 0, B_QN = 16384, B_AM = 32768, B_KNT = 40960, B_EG = 57344, B_SIZE = 57344 + 1024;
    int tid_ = threadIdx.x; asm volatile("" : "+v"(tid_) :: "memory");
    const int tid = tid_, wave = tid >> 6, lane = tid & 63, n16 = lane & 15, g = lane >> 4;
    constexpr int dir = DIR;
    const int chain = blockIdx.x, h = (chain >> 1) & 7, b = chain >> 4, bh = b * 8 + h;
    const int dv0 = wave * 16;
    bf16_t* O = dir ? p.OB : p.OF;
    auto ldst = [&](int i, int tl) -> int {
        const int q = tl + NTHREADS * i;
        if (i < 4) {
            const int qq = q & 1023, row = qq >> 4, k8 = qq & 15, kb = k8 >> 2, c4 = k8 & 3;
            const int off1 = kb * 64 + (c4 & 1) * 32 + (c4 >> 1) * 8;
            return (i < 2 ? B_WN : B_QN) + row * 256 + (off1 ^ ((row & 15) << 4));
        } else {
            const int qq = (i == 4) ? (q - 2048) : (q - 2560), row = qq >> 3, c8 = qq & 7, kb = c8 >> 2, c4 = c8 & 3;
            const int off1 = kb * 64 + (c4 & 1) * 32 + (c4 >> 1) * 8;
            return (i == 4 ? B_AM : B_KNT) + row * 128 + (off1 ^ (((row >> 1) & 7) << 4));
        }
    };
    u32x4 st[1]; u32x4 stg = (u32x4){0u, 0u, 0u, 0u}; u32x2 ut[4]; u32x4 shA[6], shB[6];
    auto issue_d = [&](int cidx) {
        const unsigned char* drec = p.DND + ((size_t)(bh * 64 + cidx) * 2 + dir) * DND_SIZE;
        st[0] = *(const u32x4*)(drec + DND_AM + tid * 16);
        if (tid < 33) stg = *(const u32x4*)(drec + DND_EG + tid * 16);
#pragma unroll
        for (int m = 0; m < 4; ++m) ut[m] = *(const u32x2*)(drec + DND_UT + ((dv0 + n16) * 64 + 16 * m + 4 * g) * 2);
    };
    auto issue_sh = [&](int cidx, u32x4 (&sh)[6]) {
        const unsigned char* srec = p.DNS + (size_t)(bh * 64 + cidx) * DNS_SIZE;
        const unsigned char* drec = p.DND + ((size_t)(bh * 64 + cidx) * 2 + dir) * DND_SIZE;
        sh[4] = *(const u32x4*)(drec + DND_WN + tid * 16); sh[5] = *(const u32x4*)(drec + DND_WN + (tid + 512) * 16);
        sh[0] = *(const u32x4*)(srec + DNS_QN + tid * 16); sh[1] = *(const u32x4*)(srec + DNS_QN + (tid + 512) * 16);
        sh[2] = *(const u32x4*)(srec + DNS_KNT + tid * 16); sh[3] = *(const u32x4*)(srec + DNS_KNT + (tid + 512) * 16);
    };
#define SC_WR(bb_, i_, v_) { const int d_ = ldst(i_, tl); *(LAS u32x2*)((bb_) + d_) = (u32x2){(v_).x, (v_).y}; *(LAS u32x2*)((bb_) + (d_ ^ 16)) = (u32x2){(v_).z, (v_).w}; }
    auto write_d = [&](int buf) {
        LAS unsigned char* bb = lds + buf * B_SIZE;
        int tl = tid; asm volatile("" : "+v"(tl));
        SC_WR(bb, 4, st[0])
        if (tid < 33) *(LAS u32x4*)(bb + B_EG + tid * 16) = stg;
    };
    auto write_sh = [&](int buf, const u32x4 (&sh)[6]) {
        LAS unsigned char* bb = lds + buf * B_SIZE;
        int tl = tid; asm volatile("" : "+v"(tl));
        SC_WR(bb, 2, sh[0]) SC_WR(bb, 3, sh[1]) SC_WR(bb, 5, sh[2]) SC_WR(bb, 6, sh[3]) SC_WR(bb, 0, sh[4]) SC_WR(bb, 1, sh[5])
    };
    f32x4 Sst[8];
#pragma unroll
    for (int mm = 0; mm < 8; ++mm) Sst[mm] = (f32x4){0.f, 0.f, 0.f, 0.f};
#pragma unroll 1
    for (int k0 = 0; k0 < 3; ++k0) XB_SPIN(xb_ld(&p.FLAG[bh * 64 + (dir ? 63 - k0 : k0)]) == 0u, p.BAR);
    issue_d(dir ? 63 : 0); issue_sh(dir ? 63 : 0, shA);
    write_d(0); write_sh(0, shA);
    issue_sh(dir ? 62 : 1, shB);
    u32x2 utc[4];
#pragma unroll
    for (int m = 0; m < 4; ++m) utc[m] = ut[m];
    __syncthreads();
    unsigned fl = 1u;
    auto step = [&](const int k, u32x4 (&shLoad)[6], const u32x4 (&shWrite)[6]) {
        const int cidx = dir ? (63 - k) : k;
        if (k + 1 < 64) issue_d(dir ? (62 - k) : (k + 1));
        if (k + 2 < 64) {
            const int c2 = dir ? (61 - k) : (k + 2);
            if (fl == 0u) XB_SPIN(xb_ld(&p.FLAG[bh * 64 + c2]) == 0u, p.BAR);
            issue_sh(c2, shLoad);
        }
        if (k + 3 < 64) { const int c3 = dir ? (60 - k) : (k + 3); fl = xb_ld(&p.FLAG[bh * 64 + c3]); }
        const LAS unsigned char* bb = lds + (k & 1) * B_SIZE;
        bf16x8 BS[4];
#pragma unroll
        for (int ks = 0; ks < 4; ++ks) {
            u32x4 w; w.x = cvt_pk_bf16(Sst[2 * ks][0], Sst[2 * ks][1]); w.y = cvt_pk_bf16(Sst[2 * ks][2], Sst[2 * ks][3]);
            w.z = cvt_pk_bf16(Sst[2 * ks + 1][0], Sst[2 * ks + 1][1]); w.w = cvt_pk_bf16(Sst[2 * ks + 1][2], Sst[2 * ks + 1][3]);
            BS[ks] = __builtin_bit_cast(bf16x8, w);
        }
        f32x4 vn[4], oq[4];
        bf16x8 fw[2][4], fq[2][4];
#define SC_LD_WQ(slot, m) { const int rowo_ = (16 * (m) + n16) * 256, sw_ = n16 << 4; \
            _Pragma("unroll") for (int ks = 0; ks < 4; ++ks) { fw[slot][ks] = *(const LAS bf16x8*)(bb + B_WN + rowo_ + ((ks * 64 + g * 16) ^ sw_)); fq[slot][ks] = *(const LAS bf16x8*)(bb + B_QN + rowo_ + ((ks * 64 + g * 16) ^ sw_)); } }
        SC_LD_WQ(0, 0)
#pragma unroll
        for (int m = 0; m < 4; ++m) {
            if (m < 3) SC_LD_WQ((m + 1) & 1, m + 1)
            vn[m] = (f32x4){__uint_as_float(utc[m].x << 16), __uint_as_float(utc[m].x & 0xffff0000u), __uint_as_float(utc[m].y << 16), __uint_as_float(utc[m].y & 0xffff0000u)};
            oq[m] = (f32x4){0.f, 0.f, 0.f, 0.f};
#pragma unroll
            for (int ks = 0; ks < 4; ++ks) { vn[m] = mfma16(fw[m & 1][ks], BS[ks], vn[m]); oq[m] = mfma16(BS[ks], fq[m & 1][ks], oq[m]); }
            oq[m] = oq[m] * *(const LAS float*)(bb + B_EG + (16 * m + n16) * 4);
        }
#undef SC_LD_WQ
        bf16x8 fa[4][2];
#pragma unroll
        for (int m = 0; m < 4; ++m) { const int rowo = (16 * m + n16) * 128, sw = ((n16 >> 1) & 7) << 4;
#pragma unroll
            for (int ks = 0; ks < 2; ++ks) if (!(DIR == 0 ? (m < 2 && ks == 1) : (m >= 2 && ks == 0))) fa[m][ks] = *(const LAS bf16x8*)(bb + B_AM + rowo + ((ks * 64 + g * 16) ^ sw)); }
        bf16x8 BV[2], BVs[2];
#pragma unroll
        for (int ks = 0; ks < 2; ++ks) {
            const f32x4 e0 = *(const LAS f32x4*)(bb + B_EG + 256 + (32 * ks + 4 * g) * 4), e1 = *(const LAS f32x4*)(bb + B_EG + 256 + (32 * ks + 16 + 4 * g) * 4);
            const f32x4 a0 = vn[2 * ks], a1 = vn[2 * ks + 1], s0 = a0 * e0, s1 = a1 * e1;
            u32x4 w; w.x = cvt_pk_bf16(a0[0], a0[1]); w.y = cvt_pk_bf16(a0[2], a0[3]); w.z = cvt_pk_bf16(a1[0], a1[1]); w.w = cvt_pk_bf16(a1[2], a1[3]);
            BV[ks] = __builtin_bit_cast(bf16x8, w);
            u32x4 ws; ws.x = cvt_pk_bf16(s0[0], s0[1]); ws.y = cvt_pk_bf16(s0[2], s0[3]); ws.z = cvt_pk_bf16(s1[0], s1[1]); ws.w = cvt_pk_bf16(s1[2], s1[3]);
            BVs[ks] = __builtin_bit_cast(bf16x8, ws);
        }
        bf16x8 fk[2][4][2];
#define SC_LD_K(slot, half) { _Pragma("unroll") for (int q4 = 0; q4 < 4; ++q4) { const int rowo_ = (16 * (4 * (half) + q4) + n16) * 128, sw_ = ((n16 >> 1) & 7) << 4; \
            _Pragma("unroll") for (int ks = 0; ks < 2; ++ks) fk[slot][q4][ks] = *(const LAS bf16x8*)(bb + B_KNT + rowo_ + ((ks * 64 + g * 16) ^ sw_)); } }
        SC_LD_K(0, 0)
#pragma unroll
        for (int m = 0; m < 4; ++m) {
#pragma unroll
            for (int ks = 0; ks < 2; ++ks) if (!(DIR == 0 ? (m < 2 && ks == 1) : (m >= 2 && ks == 0))) oq[m] = mfma16(BV[ks], fa[m][ks], oq[m]);
            u32x2 w; w.x = cvt_pk_bf16(oq[m][0], oq[m][1]); w.y = cvt_pk_bf16(oq[m][2], oq[m][3]);
            *(u32x2*)(O + ((size_t)b * S + cidx * 64 + 16 * m + n16) * 1024 + h * 128 + dv0 + 4 * g) = w;
        }
        const float gl = *(const LAS float*)(bb + B_EG + 512);
        SC_LD_K(1, 1)
#pragma unroll
        for (int mm = 0; mm < 8; ++mm) {
            Sst[mm] = Sst[mm] * gl;
#pragma unroll
            for (int ks = 0; ks < 2; ++ks) Sst[mm] = mfma16(fk[mm >> 2][mm & 3][ks], BVs[ks], Sst[mm]);
        }
#undef SC_LD_K
        if (k + 1 < 64) {
            write_d((k + 1) & 1); write_sh((k + 1) & 1, shWrite);
#pragma unroll
            for (int m = 0; m < 4; ++m) utc[m] = ut[m];
        }
        __syncthreads();
    };
#pragma unroll 1
    for (int k = 0; k < 64; k += 2) { step(k, shA, shB); step(k + 1, shB, shA); }
#undef SC_WR
}

__device__ __forceinline__ void phase_dncombine(const Params& p) {
    int tid_ = threadIdx.x; asm volatile("" : "+v"(tid_) :: "memory");
    const int tid = tid_;
    {
        const int kb = tid & 31, c = tid >> 5;
        for (int n0 = blockIdx.x * 16; n0 < D; n0 += gridDim.x * 16) {
            const int n = n0 + c;
            float a = n < D ? p.PCS[(size_t)kb * D + n] : 0.f, bsum = n < D ? p.PBW[(size_t)kb * D + n] : 0.f;
#pragma unroll
            for (int m = 1; m < 32; m <<= 1) { a += __shfl_xor(a, m); bsum += __shfl_xor(bsum, m); }
            if (kb == 0 && n < D) { p.CS[n] = a; p.BW[n] = bsum; }
        }
    }
    const int nitem = T * 8, stride = (gridDim.x * NTHREADS) >> 4;
    const int l16 = tid & 15;
    const f32x4 nw0 = *(const f32x4*)(p.dn_norm_w + 8 * l16), nw1 = *(const f32x4*)(p.dn_norm_w + 8 * l16 + 4);
    for (int base0 = (blockIdx.x * NTHREADS + tid) >> 4; base0 < nitem; base0 += 4 * stride) {
        u32x4 av[4], bv[4], zv[4];
#pragma unroll
        for (int u = 0; u < 4; ++u) {
            const int base = base0 + u * stride;
            const int bb = base < nitem ? base : base0;
            const size_t idx = (size_t)(bb >> 3) * 1024 + (bb & 7) * 128 + 8 * l16;
            av[u] = __builtin_nontemporal_load((const u32x4*)(p.OF + idx)); bv[u] = __builtin_nontemporal_load((const u32x4*)(p.OB + idx)); zv[u] = __builtin_nontemporal_load((const u32x4*)(p.DZ + idx));
        }
#pragma unroll
        for (int u = 0; u < 4; ++u) {
            const int base = base0 + u * stride;
            const int h = base & 7, t = base >> 3;
            const u32x4 a = av[u], bq = bv[u], z = zv[u];
            float o[8];
            o[0] = __uint_as_float(a.x << 16) + __uint_as_float(bq.x << 16); o[1] = __uint_as_float(a.x & 0xffff0000u) + __uint_as_float(bq.x & 0xffff0000u);
            o[2] = __uint_as_float(a.y << 16) + __uint_as_float(bq.y << 16); o[3] = __uint_as_float(a.y & 0xffff0000u) + __uint_as_float(bq.y & 0xffff0000u);
            o[4] = __uint_as_float(a.z << 16) + __uint_as_float(bq.z << 16); o[5] = __uint_as_float(a.z & 0xffff0000u) + __uint_as_float(bq.z & 0xffff0000u);
            o[6] = __uint_as_float(a.w << 16) + __uint_as_float(bq.w << 16); o[7] = __uint_as_float(a.w & 0xffff0000u) + __uint_as_float(bq.w & 0xffff0000u);
            float zz[8];
            zz[0] = __uint_as_float(z.x << 16); zz[1] = __uint_as_float(z.x & 0xffff0000u); zz[2] = __uint_as_float(z.y << 16); zz[3] = __uint_as_float(z.y & 0xffff0000u);
            zz[4] = __uint_as_float(z.z << 16); zz[5] = __uint_as_float(z.z & 0xffff0000u); zz[6] = __uint_as_float(z.w << 16); zz[7] = __uint_as_float(z.w & 0xffff0000u);
            float ss = 0.f;
#pragma unroll
            for (int i = 0; i < 8; ++i) ss = fmaf(o[i], o[i], ss);
            ss += __shfl_xor(ss, 1); ss += __shfl_xor(ss, 2); ss += __shfl_xor(ss, 4); ss += __shfl_xor(ss, 8);
            const float rn = __builtin_amdgcn_rsqf(ss * (1.0f / 128.0f) + RMS_EPS);
            float r[8];
#pragma unroll
            for (int i = 0; i < 8; ++i) r[i] = o[i] * rn * (i < 4 ? nw0[i] : nw1[i - 4]) * silu_f(zz[i]);
            u32x4 w; w.x = cvt_pk_bf16(r[0], r[1]); w.y = cvt_pk_bf16(r[2], r[3]); w.z = cvt_pk_bf16(r[4], r[5]); w.w = cvt_pk_bf16(r[6], r[7]);
            if (base < nitem) *(u32x4*)(p.MIX + (size_t)t * 2048 + 1024 + h * 128 + 8 * l16) = w;
        }
    }
}

typedef float f32x16 __attribute__((ext_vector_type(16)));
__device__ __forceinline__ f32x16 mfma32(bf16x8 a, bf16x8 b, f32x16 c) { return __builtin_amdgcn_mfma_f32_32x32x16_bf16(a, b, c, 0, 0, 0); }
__device__ __forceinline__ void phase_attn(const Params& p, LAS unsigned char* lds, int bidx, int nblk) {
    constexpr float LOG2E = 1.4426950408889634f, C1 = 0.08838834764831845f * 1.4426950408889634f;
    constexpr int L_BT = 0;
    constexpr int L_K = 8448;
    constexpr int L_V = L_K + 16384;
    int tid_ = threadIdx.x; asm volatile("" : "+v"(tid_) :: "memory");
    const int tid = tid_, wave = tid >> 6, lane = tid & 63, n = lane & 31, h2 = lane >> 5;
    LAS float* btab = (LAS float*)(lds + L_BT);
    for (int i = tid; i < 8 * 257; i += NTHREADS) { const int hq = i / 257, r = i % 257; btab[hq * 260 + r] = p.rel_bias[t5_bucket(r - 128) * 8 + hq] * LOG2E; }
    __syncthreads();
#pragma unroll 1
    for (int it = bidx; it < 512; it += nblk) {
        const int span = it & 63, kvh = (it >> 6) & 1, b = it >> 7;
        const int gq = wave & 3, hq = kvh * 4 + gq, q0 = span * 64 + (wave >> 2) * 32;
        const int kbase = span * 64 - 128;
        const int skey = tid >> 4, sc16 = tid & 15, sd = tid >> 2, sc4 = tid & 3;
        const bf16_t* kg = p.AK + ((size_t)b * S + skey) * 256 + kvh * 128 + sc16 * 8;
        const bf16_t* vg = p.AVT + (size_t)(kvh * 128 + sd) * T + (size_t)b * S + sc4 * 8;
        const int kdst = L_K + skey * 256 + ((sc16 ^ (skey & 15)) << 4), vdst = L_V + sd * 72 + sc4 * 16;
        u32x4 kst, vst;
        auto tile_ok = [&](int j) { const int k0 = kbase + 32 * j; return k0 >= 0 && k0 < S; };
        auto issue = [&](int j) { const int k0 = kbase + 32 * j; if (k0 >= 0 && k0 < S) { kst = *(const u32x4*)(kg + (size_t)k0 * 256); vst = *(const u32x4*)(vg + k0); } };
        auto stage = [&](int buf) { *(LAS u32x4*)(lds + buf * 8192 + kdst) = kst;
                                    *(LAS u32x2*)(lds + buf * 9216 + vdst) = (u32x2){vst.x, vst.y}; *(LAS u32x2*)(lds + buf * 9216 + vdst + 8) = (u32x2){vst.z, vst.w}; };
        bf16x8 qf[8];
        {
            const bf16_t* qrow = p.AQ + ((size_t)b * S + q0 + n) * 1024 + hq * 128 + 8 * h2;
#pragma unroll
            for (int ks = 0; ks < 8; ++ks) qf[ks] = *(const bf16x8*)(qrow + 16 * ks);
        }
        f32x16 o[4];
#pragma unroll
        for (int mt = 0; mt < 4; ++mt)
#pragma unroll
            for (int r = 0; r < 16; ++r) o[mt][r] = 0.f;
        float m = p.attn_sink[hq] * LOG2E, l = h2 ? 0.f : 1.f;
        const LAS float* bt = btab + hq * 260 + 128;
        issue(0);
        if (tile_ok(0)) stage(0);
        __syncthreads();
#pragma unroll 1
        for (int j = 0; j < 10; ++j) {
            if (j + 1 < 10) issue(j + 1);
            const int k0 = kbase + 32 * j, kt = (k0 - q0) / 32;
            if (k0 >= 0 && k0 < S && kt >= -4 && kt <= 4) {
                const LAS unsigned char* kb = lds + (j & 1) * 8192 + L_K;
                const LAS unsigned char* vb = lds + (j & 1) * 9216 + L_V;
                f32x16 s;
#pragma unroll
                for (int r = 0; r < 16; ++r) s[r] = 0.f;
#pragma unroll
                for (int ks = 0; ks < 8; ++ks) {
                    const bf16x8 kf = *(const LAS bf16x8*)(kb + n * 256 + (((2 * ks + h2) ^ (n & 15)) << 4));
                    s = mfma32(kf, qf[ks], s);
                }
                u32x2 vf[2][4][2];
#pragma unroll
                for (int ss = 0; ss < 2; ++ss)
#pragma unroll
                    for (int mt = 0; mt < 4; ++mt) {
                        const LAS unsigned char* vr = vb + (32 * mt + n) * 72 + (16 * ss + 4 * h2) * 2;
                        vf[ss][mt][0] = *(const LAS u32x2*)vr; vf[ss][mt][1] = *(const LAS u32x2*)(vr + 16);
                    }
                float tmax = -INFINITY;
#pragma unroll
                for (int r = 0; r < 16; ++r) {
                    const int kr = (r & 3) + 8 * (r >> 2) + 4 * h2, rel = 32 * kt + kr - n;
                    const int ri = rel < -128 ? -128 : (rel > 128 ? 128 : rel);
                    float v = fmaf(s[r], C1, bt[ri]);
                    v = (rel >= -128 && rel <= 128) ? v : -INFINITY;
                    s[r] = v; tmax = fmaxf(tmax, v);
                }
                tmax = fmaxf(tmax, __shfl_xor(tmax, 32));
                const float mn = fmaxf(m, tmax), alpha = __builtin_amdgcn_exp2f(m - mn);
                m = mn; l *= alpha;
#pragma unroll
                for (int mt = 0; mt < 4; ++mt) o[mt] = o[mt] * alpha;
#pragma unroll
                for (int r = 0; r < 16; ++r) { const float pr = __builtin_amdgcn_exp2f(s[r] - mn); l += pr; s[r] = pr; }
#pragma unroll
                for (int ss = 0; ss < 2; ++ss) {
                    u32x4 pw; pw.x = cvt_pk_bf16(s[8 * ss], s[8 * ss + 1]); pw.y = cvt_pk_bf16(s[8 * ss + 2], s[8 * ss + 3]); pw.z = cvt_pk_bf16(s[8 * ss + 4], s[8 * ss + 5]); pw.w = cvt_pk_bf16(s[8 * ss + 6], s[8 * ss + 7]);
                    const bf16x8 pf = __builtin_bit_cast(bf16x8, pw);
#pragma unroll
                    for (int mt = 0; mt < 4; ++mt) {
                        const u32x4 vw = (u32x4){vf[ss][mt][0].x, vf[ss][mt][0].y, vf[ss][mt][1].x, vf[ss][mt][1].y};
                        o[mt] = mfma32(__builtin_bit_cast(bf16x8, vw), pf, o[mt]);
                    }
                }
            }
            if (j + 1 < 10 && tile_ok(j + 1)) stage((j + 1) & 1);
            __syncthreads();
        }
        const float inv = 1.0f / (l + __shfl_xor(l, 32));
        bf16_t* orow = p.MIX + ((size_t)b * S + q0 + n) * 2048 + hq * 128 + 4 * h2;
#pragma unroll
        for (int mt = 0; mt < 4; ++mt)
#pragma unroll
            for (int r4 = 0; r4 < 4; ++r4) {
                u32x2 w; w.x = cvt_pk_bf16(o[mt][4 * r4] * inv, o[mt][4 * r4 + 1] * inv); w.y = cvt_pk_bf16(o[mt][4 * r4 + 2] * inv, o[mt][4 * r4 + 3] * inv);
                *(u32x2*)(orow + 32 * mt + 8 * r4) = w;
            }
    }
    __syncthreads();
}

template <int N> __device__ __forceinline__ void sort_desc(float (&v)[N]) {
#pragma unroll
    for (int k = 2; k <= N; k <<= 1)
#pragma unroll
        for (int j = k >> 1; j > 0; j >>= 1)
#pragma unroll
            for (int i = 0; i < N; ++i) {
                const int l = i ^ j;
                if (l > i) {
                    const float hi = fmaxf(v[i], v[l]), lo = fminf(v[i], v[l]);
                    if ((i & k) == 0) { v[i] = hi; v[l] = lo; } else { v[i] = lo; v[l] = hi; }
                }
            }
}
template <int XORMASK> __device__ __forceinline__ void merge_top16(float (&a)[16]) {
    float c[16];
#pragma unroll
    for (int i = 0; i < 16; ++i) c[i] = fmaxf(a[i], __shfl_xor(a[15 - i], XORMASK));
#pragma unroll
    for (int j = 8; j > 0; j >>= 1)
#pragma unroll
        for (int i = 0; i < 16; ++i) { const int l = i ^ j; if (l > i) { const float hi = fmaxf(c[i], c[l]), lo = fminf(c[i], c[l]); c[i] = hi; c[l] = lo; } }
#pragma unroll
    for (int i = 0; i < 16; ++i) a[i] = c[i];
}
__device__ __forceinline__ float sel4(int g, float x0, float x1, float x2, float x3) { const float lo = (g & 1) ? x1 : x0, hi = (g & 1) ? x3 : x2; return (g & 2) ? hi : lo; }

typedef __bf16 bf2_t __attribute__((ext_vector_type(2)));
__device__ __forceinline__ float dot2bf(unsigned a, unsigned b, float c) { return __builtin_amdgcn_fdot2_f32_bf16(__builtin_bit_cast(bf2_t, a), __builtin_bit_cast(bf2_t, b), c, false); }
__device__ __forceinline__ float gelu_erf(float d) { return 0.5f * d * (1.0f + erff(d * 0.7071067811865476f)); }

typedef float f32x32v __attribute__((ext_vector_type(32)));
__device__ __forceinline__ void convert_rows_fp4(const float* __restrict__ src, unsigned char* __restrict__ dst, float* __restrict__ scales, int nrows, int gw, int ngw, int lane) {
    for (int row = gw; row < nrows; row += ngw) {
        const float* r = src + (size_t)row * 2048 + 4 * lane;
        f32x4 v[8]; float amax = 0.f;
#pragma unroll
        for (int j = 0; j < 8; ++j) { v[j] = __builtin_nontemporal_load((const f32x4*)(r + 256 * j));
            amax = fmaxf(amax, fmaxf(fmaxf(fabsf(v[j][0]), fabsf(v[j][1])), fmaxf(fabsf(v[j][2]), fabsf(v[j][3])))); }
        amax = wave_max(amax);
        const float sc = amax > 0.f ? 6.0f / amax : 1.0f;
        u32x4 w;
#pragma unroll
        for (int d = 0; d < 4; ++d) {
            unsigned x = 0;
            x = __builtin_amdgcn_cvt_scalef32_pk_fp4_f32(x, v[2 * d][0] * sc, v[2 * d][1] * sc, 1.0f, 0);
            x = __builtin_amdgcn_cvt_scalef32_pk_fp4_f32(x, v[2 * d][2] * sc, v[2 * d][3] * sc, 1.0f, 1);
            x = __builtin_amdgcn_cvt_scalef32_pk_fp4_f32(x, v[2 * d + 1][0] * sc, v[2 * d + 1][1] * sc, 1.0f, 2);
            x = __builtin_amdgcn_cvt_scalef32_pk_fp4_f32(x, v[2 * d + 1][2] * sc, v[2 * d + 1][3] * sc, 1.0f, 3);
            w[d] = x;
        }
        *(u32x4*)(dst + (size_t)row * 1024 + 16 * lane) = w;
        if (lane == 0) scales[row] = 1.0f / sc;
    }
}

__device__ __forceinline__ void convert_rows_i4(const float* __restrict__ src, unsigned char* __restrict__ dst, float* __restrict__ scales, int nrows, int gw, int ngw, int lane) {
    for (int row = gw; row < nrows; row += ngw) {
        const float* r = src + (size_t)row * 2048 + 4 * lane;
        f32x4 v[8]; float amax = 0.f;
#pragma unroll
        for (int j = 0; j < 8; ++j) { v[j] = __builtin_nontemporal_load((const f32x4*)(r + 256 * j));
            amax = fmaxf(amax, fmaxf(fmaxf(fabsf(v[j][0]), fabsf(v[j][1])), fmaxf(fabsf(v[j][2]), fabsf(v[j][3])))); }
        amax = wave_max(amax);
        float ss = 0.f;
#pragma unroll
        for (int j = 0; j < 8; ++j) ss += v[j][0] * v[j][0] + v[j][1] * v[j][1] + v[j][2] * v[j][2] + v[j][3] * v[j][3];
        const float rms = sqrtf(wave_sum(ss) * (1.0f / 2048.0f));
        const float clip = fminf(amax, 2.5f * rms);
        const float sc = clip > 0.f ? 7.0f / clip : 1.0f;
        u32x4 w;
#pragma unroll
        for (int d = 0; d < 4; ++d) {
            unsigned x = 0;
#pragma unroll
            for (int n = 0; n < 8; ++n) {
                const int k = 8 * d + n;
                int code = (int)rintf(v[k >> 2][k & 3] * sc);
                code = code < -7 ? -7 : (code > 7 ? 7 : code);
                x |= ((unsigned)code & 15u) << (4 * n);
            }
            w[d] = x;
        }
        *(u32x4*)(dst + (size_t)row * 1024 + 16 * lane) = w;
        if (lane == 0) scales[row] = 1.0f / sc;
    }
}

__device__ __forceinline__ void dec_fp4_row(const u32x4 w, f32x2 (&o)[16]) {
#define DEC4(d) o[4 * d] = __builtin_amdgcn_cvt_scalef32_pk_f32_fp4(w[d], 1.0f, 0); o[4 * d + 1] = __builtin_amdgcn_cvt_scalef32_pk_f32_fp4(w[d], 1.0f, 1); \
                o[4 * d + 2] = __builtin_amdgcn_cvt_scalef32_pk_f32_fp4(w[d], 1.0f, 2); o[4 * d + 3] = __builtin_amdgcn_cvt_scalef32_pk_f32_fp4(w[d], 1.0f, 3);
    DEC4(0) DEC4(1) DEC4(2) DEC4(3)
#undef DEC4
}

template <int CTRL> __device__ __forceinline__ float dpp_src(float v) { return __int_as_float(__builtin_amdgcn_update_dpp(0, __float_as_int(v), CTRL, 0xF, 0xF, true)); }
__device__ __forceinline__ float reduce16_rows(const float (&d)[16], int lane) {
    float e1[8], e2[4], e3[2];
#pragma unroll
    for (int r = 0; r < 8; ++r) { const float x = d[r] + dpp_src<0x140>(d[r]), y = d[r + 8] + dpp_src<0x140>(d[r + 8]); e1[r] = (lane & 8) ? y : x; }
#pragma unroll
    for (int r = 0; r < 4; ++r) { const float x = e1[r] + dpp_src<0x141>(e1[r]), y = e1[r + 4] + dpp_src<0x141>(e1[r + 4]); e2[r] = (lane & 4) ? y : x; }
#pragma unroll
    for (int r = 0; r < 2; ++r) { const float x = e2[r] + dpp_src<0x1B>(e2[r]), y = e2[r + 2] + dpp_src<0x1B>(e2[r + 2]); e3[r] = (lane & 2) ? y : x; }
    const float x = e3[0] + dpp_src<0xB1>(e3[0]), y = e3[1] + dpp_src<0xB1>(e3[1]);
    float tot = (lane & 1) ? y : x;
    tot += __shfl_xor(tot, 16);
    tot += __shfl_xor(tot, 32);
    return tot;
}

__device__ __forceinline__ void gather_u_task(const Params& p, int t0, const LAS int* idx, const LAS float* gate, int lane_) {
    u32x4 rb[4][4];
#define PG_ROWE(E0, E1, PICK) (*(const u32x4*)(p.U8 + (size_t)__builtin_amdgcn_readlane((PICK) < 64 ? (E0) : (E1), (PICK) & 63) * 1024 + 16 * lane))
#pragma unroll 1
    for (int sub = 0; sub < 2; ++sub) {
        int lane = lane_; asm volatile("" : "+v"(lane) :: "memory");
        const int t = t0 + sub;
        const int e0 = idx[sub * 128 + lane], e1 = idx[sub * 128 + 64 + lane];
        const float g0 = gate[sub * 128 + lane], g1 = gate[sub * 128 + 64 + lane];
        if (sub == 0) {
#pragma unroll
            for (int q = 0; q < 4; ++q)
#pragma unroll
                for (int r = 0; r < 4; ++r) rb[q][r] = PG_ROWE(e0, e1, 4 * q + r);
        }
        int e0n = e0, e1n = e1;
        if (sub == 0) { e0n = idx[128 + lane]; e1n = idx[128 + 64 + lane]; }
        f32x32v hv;
        {
            const bf16_t* prow = p.PREB + (size_t)t * 2048 + 4 * lane;
            float mean, rstd;
            { const f32x2 pq = lane < 32 ? *(const f32x2*)(p.PART + (size_t)t * 64 + 2 * lane) : (f32x2){0.f, 0.f};
              mean = wave_sum(pq.x) * (1.0f / 2048.0f); const float var = fmaxf(wave_sum(pq.y) * (1.0f / 2048.0f) - mean * mean, 0.f); rstd = 1.0f / sqrtf(var + LN_EPS); }
#pragma unroll
            for (int j = 0; j < 8; ++j) {
                const u32x2 xb2 = *(const u32x2*)(prow + 256 * j);
                const f32x4 x = (f32x4){__uint_as_float(xb2.x << 16), __uint_as_float(xb2.x & 0xffff0000u), __uint_as_float(xb2.y << 16), __uint_as_float(xb2.y & 0xffff0000u)};
                const f32x4 gg = *(const f32x4*)(p.ln1_g + 4 * lane + 256 * j), bb = *(const f32x4*)(p.ln1_b + 4 * lane + 256 * j);
                const f32x4 hh = (x - mean) * rstd * gg + bb;
                hv[4 * j] = hh[0]; hv[4 * j + 1] = hh[1]; hv[4 * j + 2] = hh[2]; hv[4 * j + 3] = hh[3];
            }
        }
        const float us0 = p.US[e0], us1 = p.US[e1], vs0 = p.VS[e0], vs1 = p.VS[e1];
        float c0 = 0.f, c1 = 0.f;
        int hd0[4], hd1[4]; float ish;
        {
            float hm = 0.f;
#pragma unroll
            for (int k = 0; k < 32; ++k) hm = fmaxf(hm, fabsf(hv[k]));
            hm = wave_max(hm);
            const float sh = hm > 0.f ? 119.0f / hm : 1.0f;
            ish = 1.0f / sh;
#pragma unroll
            for (int d = 0; d < 4; ++d) {
                unsigned w0 = 0u, w1 = 0u;
#pragma unroll
                for (int n = 0; n < 8; ++n) {
                    const int H = (int)rintf(hv[8 * d + n] * sh);
                    w0 |= ((unsigned)H & 15u) << (4 * n);
                    w1 |= ((unsigned)((H + 8) >> 4) & 15u) << (4 * n);
                }
                hd0[d] = (int)w0; hd1[d] = (int)w1;
            }
        }
#pragma unroll 1
        for (int it = 0; it < 8; ++it) {
            const int se0 = it < 7 ? e0 : e0n, se1 = it < 7 ? e1 : e1n;
            float dd[16];
#pragma unroll
            for (int q = 0; q < 4; ++q) {
                const int pp = 16 * it + 4 * q;
#pragma unroll
                for (int r = 0; r < 4; ++r) {
                    int a0 = 0, a1 = 0;
#pragma unroll
                    for (int d = 0; d < 4; ++d) { a0 = __builtin_amdgcn_sdot8((int)rb[q][r][d], hd0[d], a0, false); a1 = __builtin_amdgcn_sdot8((int)rb[q][r][d], hd1[d], a1, false); }
                    dd[4 * q + r] = (float)(a1 * 16 + a0);
                }
                {
#pragma unroll
                    for (int r = 0; r < 4; ++r) rb[q][r] = PG_ROWE(se0, se1, (pp + 16 + r) & 127);
                }
            }
            const float tot = reduce16_rows(dd, lane);
            if ((lane >> 4) == (it & 3)) { if (it < 4) c0 = tot; else c1 = tot; }
        }
        c0 = gelu_erf(c0 * (us0 * ish)) * g0 * vs0; c1 = gelu_erf(c1 * (us1 * ish)) * g1 * vs1;
        p.EIDX[(size_t)t * 128 + lane] = e0; p.EIDX[(size_t)t * 128 + 64 + lane] = e1;
        p.GATE[(size_t)t * 128 + lane] = c0; p.GATE[(size_t)t * 128 + 64 + lane] = c1;
    }
#undef PG_ROWE
}

__device__ __forceinline__ void phase_gather_v(const Params& p, LAS unsigned char* lds) {
    int tid_ = threadIdx.x; asm volatile("" : "+v"(tid_) :: "memory");
    const int lane_ = tid_ & 63;
    const int NGW = gridDim.x * 8;
    LAS unsigned* pool = (LAS unsigned*)(lds + 1024);
    if (tid_ == 0) *pool = 0u;
    __syncthreads();
    auto grab = [&]() -> int {
        unsigned i = 0u;
        if (lane_ == 0) i = __hip_atomic_fetch_add(pool, 1u, __ATOMIC_RELAXED, __HIP_MEMORY_SCOPE_WORKGROUP);
        i = (unsigned)__builtin_amdgcn_readfirstlane((int)i);
        const int tt = (int)blockIdx.x * 16 + (int)(i & 15u) + 2 * NGW * (int)(i >> 4);
        return (i < 4096u && tt < T) ? tt : T;
    };
    int t = grab();
    if (t < T) {
    int e0 = p.EIDX[(size_t)t * 128 + lane_], e1 = p.EIDX[(size_t)t * 128 + 64 + lane_];
    float c0 = p.GATE[(size_t)t * 128 + lane_], c1 = p.GATE[(size_t)t * 128 + 64 + lane_];
    u32x4 rb[4][4];
#define PV_ROW(E0, E1, PICK) (*(const u32x4*)(p.V8 + (size_t)__builtin_amdgcn_readlane((PICK) < 64 ? (E0) : (E1), (PICK) & 63) * 1024 + 16 * lane))
    { const int lane = lane_;
#pragma unroll
      for (int q = 0; q < 4; ++q)
#pragma unroll
          for (int r = 0; r < 4; ++r) rb[q][r] = PV_ROW(e0, e1, 4 * q + r); }
#pragma unroll 1
    while (t < T) {
        int lane = lane_; asm volatile("" : "+v"(lane) :: "memory");
        const int tn = grab(); const bool hn = tn < T;
        int e0n = e0, e1n = e1; float c0n = 0.f, c1n = 0.f;
        if (hn) { e0n = p.EIDX[(size_t)tn * 128 + lane]; e1n = p.EIDX[(size_t)tn * 128 + 64 + lane]; c0n = p.GATE[(size_t)tn * 128 + lane]; c1n = p.GATE[(size_t)tn * 128 + 64 + lane]; }
        u32x2 xr[8];
        const bf16_t* prow = p.PREB + (size_t)t * 2048 + 4 * lane;
#pragma unroll
        for (int j = 0; j < 8; ++j) xr[j] = __builtin_nontemporal_load((const u32x2*)(prow + 256 * j));
        const f32x2 pq = lane < 32 ? *(const f32x2*)(p.PART + (size_t)t * 64 + 2 * lane) : (f32x2){0.f, 0.f};
        f32x32v acc;
#pragma unroll
        for (int k = 0; k < 32; ++k) acc[k] = 0.f;
#pragma unroll 1
        for (int it = 0; it < 8; ++it) {
            const int se0 = it < 7 ? e0 : e0n, se1 = it < 7 ? e1 : e1n;
#pragma unroll
            for (int q = 0; q < 4; ++q) {
                const int pp = 16 * it + 4 * q;
#pragma unroll
                for (int r = 0; r < 4; ++r) {
                    const float cf = __uint_as_float(__builtin_amdgcn_readlane(__float_as_uint(pp < 64 ? c0 : c1), (pp + r) & 63));
                    const f32x2 cf2 = (f32x2){cf, cf};
                    f32x2 vv[16];
                    dec_fp4_row(rb[q][r], vv);
#pragma unroll
                    for (int k = 0; k < 32; k += 2) {
                        const f32x2 a2 = __builtin_elementwise_fma(vv[k >> 1], cf2, (f32x2){acc[k], acc[k + 1]});
                        acc[k] = a2.x; acc[k + 1] = a2.y;
                    }
                }
                {
#pragma unroll
                    for (int r = 0; r < 4; ++r) rb[q][r] = PV_ROW(se0, se1, (pp + 16 + r) & 127);
                }
            }
        }
        const float mean = wave_sum(pq.x) * (1.0f / 2048.0f), rstd = 1.0f / sqrtf(fmaxf(wave_sum(pq.y) * (1.0f / 2048.0f) - mean * mean, 0.f) + LN_EPS);
        float s = 0.f;
#pragma unroll
        for (int j = 0; j < 8; ++j) {
            const f32x4 x = (f32x4){__uint_as_float(xr[j].x << 16), __uint_as_float(xr[j].x & 0xffff0000u), __uint_as_float(xr[j].y << 16), __uint_as_float(xr[j].y & 0xffff0000u)};
            const f32x4 gg = *(const f32x4*)(p.ln1_g + 4 * lane + 256 * j), bb = *(const f32x4*)(p.ln1_b + 4 * lane + 256 * j);
            const f32x4 hh = (x - mean) * rstd * gg + bb;
#pragma unroll
            for (int i = 0; i < 4; ++i) { acc[4 * j + i] = acc[4 * j + i] + ALPHA * hh[i]; s += acc[4 * j + i]; }
        }
        const float mean2 = wave_sum(s) * (1.0f / 2048.0f);
        float q2 = 0.f;
#pragma unroll
        for (int k = 0; k < 32; ++k) { acc[k] = acc[k] - mean2; q2 = fmaf(acc[k], acc[k], q2); }
        const float rstd2 = 1.0f / sqrtf(wave_sum(q2) * (1.0f / 2048.0f) + LN_EPS);
        float* orow = p.out + (size_t)t * 2048 + 4 * lane;
#pragma unroll
        for (int j = 0; j < 8; ++j) {
            const f32x4 g = *(const f32x4*)(p.ln2_g + 4 * lane + 256 * j), bb = *(const f32x4*)(p.ln2_b + 4 * lane + 256 * j);
            const f32x4 a4 = (f32x4){acc[4 * j], acc[4 * j + 1], acc[4 * j + 2], acc[4 * j + 3]};
            __builtin_nontemporal_store(a4 * rstd2 * g + bb, (f32x4*)(orow + 256 * j));
        }
        e0 = e0n; e1 = e1n; c0 = c0n; c1 = c1n;
        t = tn;
    }
#undef PV_ROW
    }
}

__device__ __forceinline__ void stage_peer_keys(const Params& p, LAS unsigned char* lds) {
    for (int i = (int)threadIdx.x - 64; i < 2 * 128 * 16; i += NTHREADS - 64) {
        const int row = i >> 4, c8 = i & 15;
        const f32x4 a = *(const f32x4*)(p.peer_keys + (size_t)row * 128 + c8 * 8), b = *(const f32x4*)(p.peer_keys + (size_t)row * 128 + c8 * 8 + 4);
        u32x4 o; o.x = cvt_pk_bf16(a[0], a[1]); o.y = cvt_pk_bf16(a[2], a[3]); o.z = cvt_pk_bf16(b[0], b[1]); o.w = cvt_pk_bf16(b[2], b[3]);
        *(LAS u32x4*)(lds + row * 272 + c8 * 16) = o;
    }
}

__device__ __forceinline__ void phase_select_gather_impl(const Params& p, LAS unsigned char* lds) {
    constexpr int CA[52] = {0, 0, 0, 0, 0, 0, 0, 0, 0, 0, 0, 0, 0, 0, 0, 0, 1, 1, 1, 1, 1, 1, 1, 1, 2, 2, 2, 2, 2, 3, 3, 3, 3, 4, 4, 4, 5, 5, 6, 6, 7, 7, 8, 9, 10, 11, 12, 13, 14, 15, -1, -1};
    constexpr int CB[52] = {0, 1, 2, 3, 4, 5, 6, 7, 8, 9, 10, 11, 12, 13, 14, 15, 0, 1, 2, 3, 4, 5, 6, 7, 0, 1, 2, 3, 4, 0, 1, 2, 3, 0, 1, 2, 0, 1, 0, 1, 0, 1, 0, 0, 0, 0, 0, 0, 0, 0, -1, -1};
    constexpr int L_KEYS = 0;
    constexpr int L_TAB = 69632;
    constexpr int L_SCR = 69632 + 128;
    constexpr int L_PK = L_SCR + 8 * 2048;
    int tid_ = threadIdx.x; asm volatile("" : "+v"(tid_) :: "memory");
    const int tid = tid_, wave = tid >> 6, lane = tid & 63, n16 = lane & 15, g = lane >> 4;
    if (tid < 52) {
        int a = 0, b = 0;
#pragma unroll
        for (int c = 0; c < 52; ++c) if (tid == c) { a = CA[c] < 0 ? 0 : CA[c]; b = CB[c] < 0 ? 0 : CB[c]; }
        *(LAS unsigned char*)(lds + L_TAB + tid) = (unsigned char)a; *(LAS unsigned char*)(lds + L_TAB + 64 + tid) = (unsigned char)b;
    }
    __syncthreads();
    LAS float* scr = (LAS float*)(lds + L_SCR + wave * 2048);
    const int gw = blockIdx.x * 8 + wave, NGW = gridDim.x * 8;
    LAS unsigned* pool = (LAS unsigned*)(lds + L_PK + 8 * 4096);
    if (tid == 0) *pool = 0u;
    __syncthreads();
    auto grab = [&]() -> int {
        unsigned i = 0u;
        if (lane == 0) i = __hip_atomic_fetch_add(pool, 1u, __ATOMIC_RELAXED, __HIP_MEMORY_SCOPE_WORKGROUP);
        i = (unsigned)__builtin_amdgcn_readfirstlane((int)i);
        const int tk = (int)blockIdx.x * 8 + (int)(i & 7u) + NGW * (int)(i >> 3);
        return (i < 4096u && tk < T * 8 / 16) ? tk : T;
    };
    int task = grab();
#pragma unroll 1
    for (int ti = 0; task < T * 8 / 16; ++ti) {
        const int selTask = ti;
        if (selTask >= 0) {
        int lane_s = lane; asm volatile("" : "+v"(lane_s) :: "memory");
        const int n16 = lane_s & 15, g = lane_s >> 4;
        LAS int* pkidx = (LAS int*)(lds + L_PK + wave * 4096 + (selTask & 1) * 2048);
        LAS float* pkgate = (LAS float*)(lds + L_PK + wave * 4096 + (selTask & 1) * 2048 + 1024);
        const int item = task * 16 + n16, t = item >> 3, hd = item & 7;
        float sv[2][16];
#pragma unroll
        for (int pp = 0; pp < 2; ++pp) {
            bf16x8 qf[4];
            const bf16_t* qrow = p.QP + (size_t)t * 2048 + hd * 256 + pp * 128 + 8 * g;
#pragma unroll
            for (int ks = 0; ks < 4; ++ks) qf[ks] = __builtin_nontemporal_load((const bf16x8*)(qrow + 32 * ks));
            float v[32];
#pragma unroll
            for (int kt = 0; kt < 8; ++kt) {
                f32x4 acc = (f32x4){0.f, 0.f, 0.f, 0.f};
#pragma unroll
                for (int ks = 0; ks < 4; ++ks) {
                    const bf16x8 kf = *(const LAS bf16x8*)(lds + L_KEYS + (pp * 128 + 16 * kt + n16) * 272 + ks * 64 + g * 16);
                    acc = mfma16(kf, qf[ks], acc);
                }
#pragma unroll
                for (int rr = 0; rr < 4; ++rr) v[4 * kt + rr] = __uint_as_float((__float_as_uint(acc[rr]) & 0xFFFFFF80u) | (unsigned)(16 * kt + 4 * g + rr));
            }
            sort_desc<32>(v);
            float top[16];
#pragma unroll
            for (int r = 0; r < 16; ++r) top[r] = v[r];
            merge_top16<16>(top); merge_top16<32>(top);
#pragma unroll
            for (int r = 0; r < 16; ++r) sv[pp][r] = top[r];
        }
        if (g == 0) {
#pragma unroll
            for (int r = 0; r < 16; ++r) { scr[n16 * 32 + r] = sv[0][r]; scr[n16 * 32 + 16 + r] = sv[1][r]; }
        }
        float cs[16];
#pragma unroll
        for (int s = 0; s < 13; ++s) {
            const int c0 = 4 * s;
            const float a = sel4(g, sv[0][CA[c0] < 0 ? 0 : CA[c0]], sv[0][CA[c0 + 1] < 0 ? 0 : CA[c0 + 1]], sv[0][CA[c0 + 2] < 0 ? 0 : CA[c0 + 2]], sv[0][CA[c0 + 3] < 0 ? 0 : CA[c0 + 3]]);
            const float b = sel4(g, sv[1][CB[c0] < 0 ? 0 : CB[c0]], sv[1][CB[c0 + 1] < 0 ? 0 : CB[c0 + 1]], sv[1][CB[c0 + 2] < 0 ? 0 : CB[c0 + 2]], sv[1][CB[c0 + 3] < 0 ? 0 : CB[c0 + 3]]);
            float sum = __uint_as_float((__float_as_uint(a + b) & 0xFFFFFFC0u) | (unsigned)(c0 + g));
            if (s == 12) sum = (g >= 2) ? -INFINITY : sum;
            cs[s] = sum;
        }
        cs[13] = -INFINITY; cs[14] = -INFINITY; cs[15] = -INFINITY;
        sort_desc<16>(cs);
        merge_top16<16>(cs); merge_top16<32>(cs);
        float ts[16];
#pragma unroll
        for (int r = 0; r < 16; ++r) ts[r] = cs[r];
        float den = 0.f, e[16];
#pragma unroll
        for (int r = 0; r < 16; ++r) { e[r] = __expf(ts[r] - ts[0]); den += e[r]; }
        const float inv = 1.0f / den;
#pragma unroll
        for (int k = 0; k < 4; ++k) {
            const float tv = sel4(g, ts[k], ts[4 + k], ts[8 + k], ts[12 + k]);
            const float ev = sel4(g, e[k], e[4 + k], e[8 + k], e[12 + k]);
            const int c = (int)(__float_as_uint(tv) & 63u);
            const int a = *(const LAS unsigned char*)(lds + L_TAB + c), b = *(const LAS unsigned char*)(lds + L_TAB + 64 + c);
            const int e0 = (int)(__float_as_uint(scr[n16 * 32 + a]) & 127u), e1 = (int)(__float_as_uint(scr[n16 * 32 + 16 + b]) & 127u);
            const int oi = (n16 >> 3) * 128 + hd * 16 + 4 * g + k;
            pkidx[oi] = e0 * 128 + e1;
            pkgate[oi] = ev * inv;
        }
        asm volatile("s_waitcnt lgkmcnt(0)" ::: "memory");
        }
        gather_u_task(p, task * 2, (const LAS int*)(lds + L_PK + wave * 4096 + (ti & 1) * 2048), (const LAS float*)(lds + L_PK + wave * 4096 + (ti & 1) * 2048 + 1024), lane);
        task = grab();
        asm volatile("s_waitcnt lgkmcnt(0)" ::: "memory");
    }
    asm volatile("s_waitcnt vmcnt(0)" ::: "memory");
    __syncthreads();
}

__global__ void __launch_bounds__(NTHREADS, 2) mega(Params p) {
    extern __shared__ __attribute__((aligned(16))) unsigned char dyn_lds[];
    LAS unsigned char* lds = (LAS unsigned char*)dyn_lds;
    cg::grid_group grid = cg::this_grid();
    const int G = gridDim.x;
    volatile LAS unsigned* xbw = (volatile LAS unsigned*)(lds + LDS_BYTES - 16);
    if (threadIdx.x == 0) { xbw[0] = 0u; xbw[1] = 0u; }
    __syncthreads();
    const XcdBarrier xb = xcd_barrier_post(p.BAR, xbw);
    phase_prep(p, lds);
    xcd_barrier(xb);
    { pg8::Gemm g{p.R, p.R, D}; pg8::ProjOrder so; so.init(G, blockIdx.x);
      pg8::EpiProj E{p.AQ, p.AK, p.AVT, p.DQ, p.DK, p.DV, p.DZ, p.BG};
      pg8::gemm_phase(lds, g, so, E); }
    xcd_barrier(xb);
    phase_dnprep<2>(p, lds);
    __syncthreads();
    if (blockIdx.x < 64) { if (blockIdx.x & 1) phase_dnscan<1>(p, lds); else phase_dnscan<0>(p, lds); }
    else {
        phase_dnprep<1>(p, lds);
        phase_attn(p, lds, blockIdx.x - 64, G - 64);
        phase_prep_late(p, lds, blockIdx.x - 64, G - 64);
        int tid_ = threadIdx.x; asm volatile("" : "+v"(tid_) :: "memory");
        const int wave = tid_ >> 6, lane = tid_ & 63, gw = (blockIdx.x - 64) * 8 + wave, ngw = (G - 64) * 8;
        convert_rows_i4(p.peer_u, p.U8, p.US, 16384, gw, ngw, lane);
        convert_rows_fp4(p.peer_v, p.V8, p.VS, 16384, gw, ngw, lane);
    }
    grid.sync();
    phase_dncombine(p);
    xcd_barrier(xb);
    { pg8::Gemm g{p.MIX, p.WOUTT, D}; pg8::StaticOrder so; so.init(64, 8, G, blockIdx.x);
      pg8::EpiResBf16 E{p.PREB, p.x, D, ALPHA, p.PART};
      pg8::gemm_phase(lds, g, so, E); }
    xcd_barrier(xb);
    { pg8::Gemm g{p.PREB, p.WQT, D}; pg8::StaticOrder so; so.init(64, 8, G, blockIdx.x);
      pg8::EpiLnQ E{p.QP, D, p.PART, p.CS, p.BW};
      pg8::gemm_phase(lds, g, so, E); }
    xcd_barrier(xb, [&]() { stage_peer_keys(p, lds); });
    phase_select_gather_impl(p, lds);
    phase_gather_v(p, lds);
}
}

extern "C" void kernel_launch(void* const* d_in, const int* in_sizes, int n_in, void* d_out, int out_size, void* d_ws, size_t ws_size, hipStream_t stream) {
    if (n_in != 17 || out_size != T * D || ws_size < 500 * MB) { fprintf(stderr, "kernel_launch: unexpected sizes n_in %d out %d ws %zu\n", n_in, out_size, ws_size); return; }
    static int grid_blocks = 0;
    if (!grid_blocks) {
        int dev = 0, cus = 0, per_cu = 0;
        (void)hipGetDevice(&dev);
        (void)hipDeviceGetAttribute(&cus, hipDeviceAttributeMultiprocessorCount, dev);
        if (hipFuncSetAttribute((const void*)mega, hipFuncAttributeMaxDynamicSharedMemorySize, LDS_BYTES) != hipSuccess) fprintf(stderr, "kernel_launch: hipFuncSetAttribute failed\n");
        (void)hipOccupancyMaxActiveBlocksPerMultiprocessor(&per_cu, (const void*)mega, NTHREADS, LDS_BYTES);
        if (per_cu < 1) { fprintf(stderr, "kernel_launch: occupancy query says %d\n", per_cu); per_cu = 1; }
        grid_blocks = cus;
        fprintf(stderr, "kernel_launch: cus %d per_cu %d grid %d\n", cus, per_cu, grid_blocks);
    }
    char* ws = (char*)d_ws;
    Params p;
    memset(&p, 0, sizeof(p));
    p.x = (const float*)d_in[0]; p.w_in = (const float*)d_in[1]; p.conv_w = (const float*)d_in[2]; p.a_log = (const float*)d_in[3]; p.dt_bias = (const float*)d_in[4];
    p.dn_norm_w = (const float*)d_in[5]; p.attn_sink = (const float*)d_in[6]; p.rel_bias = (const float*)d_in[7]; p.w_out = (const float*)d_in[8];
    p.ln1_g = (const float*)d_in[9]; p.ln1_b = (const float*)d_in[10]; p.peer_wq = (const float*)d_in[11]; p.peer_keys = (const float*)d_in[12];
    p.peer_u = (const float*)d_in[13]; p.peer_v = (const float*)d_in[14]; p.ln2_g = (const float*)d_in[15]; p.ln2_b = (const float*)d_in[16];
    p.out = (float*)d_out;
    p.R = (bf16_t*)(ws + 0 * MB);
    p.AQ = (bf16_t*)(ws + 88 * MB);
    p.AK = (bf16_t*)(ws + 120 * MB);
    p.AVT = (bf16_t*)(ws + 128 * MB);
    p.DQ = (bf16_t*)(ws + 136 * MB);
    p.DK = (bf16_t*)(ws + 168 * MB);
    p.DV = (bf16_t*)(ws + 200 * MB);
    p.DZ = (bf16_t*)(ws + 232 * MB);
    p.BG = (float*)(ws + 264 * MB);
    p.WOUTT = (bf16_t*)(ws + 266 * MB);
    p.WQT = (bf16_t*)(ws + 274 * MB);
    p.MIX = (bf16_t*)(ws + 0 * MB);
    p.DND = (unsigned char*)(ws + 282 * MB);
    p.DNS = (unsigned char*)d_out + 64 * MB;
    p.OF = (bf16_t*)d_out;
    p.OB = (bf16_t*)((char*)d_out + 32 * MB);
    p.PREB = (bf16_t*)(ws + 282 * MB);
    p.HB = (bf16_t*)(ws + 0 * MB);
    p.QP = (bf16_t*)(ws + 66 * MB);
    p.EIDX = (int*)(ws + 346 * MB);
    p.GATE = (float*)(ws + 354 * MB);
    p.V8 = (unsigned char*)(ws + 446 * MB);
    p.U8 = (unsigned char*)(ws + 462 * MB);
    p.US = (float*)(ws + 478 * MB);
    p.VS = (float*)(ws + 479 * MB);
    p.PART = (float*)(ws + 202 * MB);
    p.PCS = (float*)(ws + 480 * MB);
    p.PBW = (float*)(ws + 481 * MB);
    p.CS = (float*)(ws + 208 * MB);
    p.BW = (float*)(ws + 208 * MB + 16384);
    p.BAR = (unsigned*)(ws + 490 * MB);
    p.FLAG = p.BAR + 4096;
    (void)hipMemsetAsync(p.BAR, 0, (4096 + 2048) * 4, stream);
    void* args[] = {&p};
    hipError_t e = hipLaunchCooperativeKernel((const void*)mega, dim3(grid_blocks), dim3(NTHREADS), args, LDS_BYTES, stream);
    if (e != hipSuccess) fprintf(stderr, "cooperative launch failed: %s (grid %d)\n", hipGetErrorString(e), grid_blocks);
}
```
